# Optimizing an MI355X kernel written in HIP

```python
import math
import jax, jax.numpy as jnp
from jax import lax
import numpy as np

D_MODEL = 1024
BATCH = 32
SEQ = 256
DEPTH = 2
DEC_BATCH = 2
DEC_SEQ = 4096
PAST_LEN = 512

GRID_W = 64
Q_BLOCK = 128
RMS_EPS = 1e-6
ROPE_THETA = 10000.0
MLA_HEADS = 8
MLA_NOPE = 64
MLA_ROPE = 32
MLA_V = 64
Q_LORA = 256
KV_LORA = 128
GQA_HEADS = 8
GQA_KV_HEADS = 2
GQA_HEAD_DIM = 64
POOL_WINDOWS = (2, 4, 8, 16)
POOL_GROUP = 128
POOL_WIDTH = POOL_GROUP * len(POOL_WINDOWS)
D_FF = 2816
N_BRANCH = 3
MLA_OUT = MLA_HEADS * MLA_V
GQA_OUT = GQA_HEADS * GQA_HEAD_DIM
IN_SPLITS = (Q_LORA, KV_LORA + MLA_ROPE, GQA_HEADS * GQA_HEAD_DIM, GQA_KV_HEADS * GQA_HEAD_DIM,
             GQA_KV_HEADS * GQA_HEAD_DIM, POOL_WIDTH, N_BRANCH * D_MODEL)
IN_COLS = Q_LORA + KV_LORA + MLA_ROPE + (GQA_HEADS + 2 * GQA_KV_HEADS) * GQA_HEAD_DIM + POOL_WIDTH + N_BRANCH * D_MODEL

kernel_name = "hybrid_diffusion_mla_gqa_pool_convffn_step"


def rms_norm(x, g):
    xf = x.astype(jnp.float32)
    xf = xf * lax.rsqrt(jnp.mean(xf * xf, axis=-1, keepdims=True) + RMS_EPS)
    return xf.astype(x.dtype) * g


def split_cols(z):
    outs = []
    start = 0
    for w in IN_SPLITS:
        outs.append(z[..., start:start + w])
        start += w
    return outs


def axial_angles(n_tokens, dim_axis):
    n_rows = n_tokens // GRID_W
    row = jnp.repeat(jnp.arange(n_rows), GRID_W).astype(jnp.float32)
    col = jnp.tile(jnp.arange(GRID_W), n_rows).astype(jnp.float32)
    freqs = ROPE_THETA ** (-jnp.arange(0, dim_axis, 2, dtype=jnp.float32) / dim_axis)
    return row[:, None] * freqs[None, :], col[:, None] * freqs[None, :]


def rope_rotate(x, ang):
    half = x.shape[-1] // 2
    x1, x2 = x[..., :half], x[..., half:]
    cos = jnp.cos(ang)[None, :, None, :].astype(x.dtype)
    sin = jnp.sin(ang)[None, :, None, :].astype(x.dtype)
    return jnp.concatenate([x1 * cos - x2 * sin, x1 * sin + x2 * cos], axis=-1)


def axial_rope(x):
    T, d = x.shape[1], x.shape[-1]
    ang_row, ang_col = axial_angles(T, d // 2)
    h = d // 2
    return jnp.concatenate([rope_rotate(x[..., :h], ang_row), rope_rotate(x[..., h:], ang_col)], axis=-1)


def block_attention(q, k, v):
    B, T, H, D = q.shape
    G = k.shape[2]
    R = H // G
    Dv = v.shape[-1]
    scale = D ** -0.5
    qb = q.reshape(B, T // Q_BLOCK, Q_BLOCK, G, R, D).transpose(1, 0, 2, 3, 4, 5)

    def one_block(qi):
        s = jnp.einsum('bqgrd,bsgd->bgrqs', qi, k).astype(jnp.float32) * scale
        pr = jax.nn.softmax(s, axis=-1).astype(v.dtype)
        return jnp.einsum('bgrqs,bsgv->bqgrv', pr, v)

    o = lax.map(one_block, qb)
    return o.transpose(1, 0, 2, 3, 4, 5).reshape(B, T, H * Dv)


def pool_mixer(u, w_pool, pool_scale):
    B, T, _ = u.shape
    uf = u.astype(jnp.float32)
    cs = jnp.concatenate([jnp.zeros((B, 1, POOL_WIDTH), jnp.float32), jnp.cumsum(uf, axis=1)], axis=1)
    t = jnp.arange(T)
    pooled = []
    for g, w in enumerate(POOL_WINDOWS):
        lo = jnp.clip(t - w // 2, 0, T)
        hi = jnp.clip(t - w // 2 + w, 0, T)
        seg = cs[:, :, g * POOL_GROUP:(g + 1) * POOL_GROUP]
        cnt = (hi - lo).astype(jnp.float32)[None, :, None]
        pooled.append((seg[:, hi] - seg[:, lo]) / cnt)
    pooled = jnp.concatenate(pooled, axis=-1) - uf
    pooled = pooled.astype(u.dtype).reshape(B, T, len(POOL_WINDOWS), POOL_GROUP)
    out = jnp.einsum('btgc,gcd->btgd', pooled, w_pool).reshape(B, T, POOL_WIDTH)
    return out * pool_scale


def conv_ffn(h, w_up, conv_w, conv_b, w_down):
    u = h @ w_up
    g, val = u[..., :D_FF], u[..., D_FF:]
    gp = jnp.pad(g, ((0, 0), (1, 1), (0, 0)))
    g = gp[:, :-2] * conv_w[0] + gp[:, 1:-1] * conv_w[1] + gp[:, 2:] * conv_w[2] + conv_b
    return (jax.nn.silu(g) * val) @ w_down


def trunk_layer(x, mod, p, cache=None):
    B, T, _ = x.shape
    sh1, sc1, g1, sh2, sc2, g2 = jnp.split(mod, 6, axis=-1)
    h = rms_norm(x, p['g_norm_mix']) * (1 + sc1) + sh1
    q_a, kv_a, gq, gk, gv, pool_in, gate_logits = split_cols(h @ p['w_in'])
    q_mla = (rms_norm(q_a, p['g_q_a']) @ p['w_q_b']).reshape(B, T, MLA_HEADS, MLA_NOPE + MLA_ROPE)
    ckv = rms_norm(kv_a[..., :KV_LORA], p['g_kv_a'])
    krope = kv_a[..., KV_LORA:]
    q_gqa = rms_norm(gq.reshape(B, T, GQA_HEADS, GQA_HEAD_DIM), p['g_q_gqa'])
    k_gqa = rms_norm(gk.reshape(B, T, GQA_KV_HEADS, GQA_HEAD_DIM), p['g_k_gqa'])
    v_gqa = gv.reshape(B, T, GQA_KV_HEADS, GQA_HEAD_DIM)
    if cache is None:
        new_state = (ckv, krope, k_gqa, v_gqa)
        ckv_all, krope_all, k_all, v_all = ckv, krope, k_gqa, v_gqa
    else:
        c_ckv, c_krope, c_k, c_v = cache
        q_mla = jnp.concatenate([q_mla[..., :MLA_NOPE], axial_rope(q_mla[..., MLA_NOPE:])], axis=-1)
        krope = axial_rope(krope[:, :, None, :])[:, :, 0, :]
        q_gqa = axial_rope(q_gqa)
        k_gqa = axial_rope(k_gqa)
        ckv_all = jnp.concatenate([ckv, c_ckv], axis=1)
        krope_all = jnp.concatenate([krope, c_krope], axis=1)
        k_all = jnp.concatenate([k_gqa, c_k], axis=1)
        v_all = jnp.concatenate([v_gqa, c_v], axis=1)
        new_state = None
    S = ckv_all.shape[1]
    kv = (ckv_all @ p['w_kv_b']).reshape(B, S, MLA_HEADS, MLA_NOPE + MLA_V)
    k_mla = jnp.concatenate([kv[..., :MLA_NOPE],
                             jnp.broadcast_to(krope_all[:, :, None, :], (B, S, MLA_HEADS, MLA_ROPE))], axis=-1)
    a_out = block_attention(q_mla, k_mla, kv[..., MLA_NOPE:])
    b_out = block_attention(q_gqa, k_all, v_all)
    c_out = pool_mixer(pool_in, p['w_pool'], p['pool_scale'])
    gates = jax.nn.sigmoid(gate_logits)
    ga, gb, gc = jnp.split(gates, N_BRANCH, axis=-1)
    merged = ga * (a_out @ p['w_br_a']) + gb * (b_out @ p['w_br_b']) + gc * (c_out @ p['w_br_c'])
    x = x + g1 * (merged @ p['w_out'])
    h2 = rms_norm(x, p['g_norm_ffn']) * (1 + sc2) + sh2
    x = x + g2 * conv_ffn(h2, p['w_up'], p['conv_w'], p['conv_b'], p['w_down'])
    return x, new_state


def setup_inputs(seed: int = 0) -> dict:
    key = jax.random.key(seed)
    ks = jax.random.split(key, 40)
    f32 = jnp.float32

    def nrm(k, shape, scale=1.0):
        return jax.random.normal(k, shape, f32) * scale

    def gain(k, shape):
        return 1.0 + 0.1 * jax.random.normal(k, shape, f32)

    L = DEPTH
    return {
        'x_prompt': nrm(ks[0], (BATCH, SEQ, D_MODEL)),
        'x_sample': nrm(ks[1], (DEC_BATCH, DEC_SEQ, D_MODEL)),
        'c': nrm(ks[2], (DEC_BATCH, D_MODEL)),
        'cache_mla_ckv': nrm(ks[3], (DEC_BATCH, L, PAST_LEN, KV_LORA)),
        'cache_mla_krope': nrm(ks[4], (DEC_BATCH, L, PAST_LEN, MLA_ROPE)),
        'cache_gqa_k': nrm(ks[5], (DEC_BATCH, L, PAST_LEN, GQA_KV_HEADS, GQA_HEAD_DIM)),
        'cache_gqa_v': nrm(ks[6], (DEC_BATCH, L, PAST_LEN, GQA_KV_HEADS, GQA_HEAD_DIM)),
        'c_ctx': nrm(ks[7], (D_MODEL,)),
        'w_ada': nrm(ks[8], (L, D_MODEL, 6 * D_MODEL), 0.5 * D_MODEL ** -0.5),
        'b_ada': nrm(ks[9], (L, 6 * D_MODEL), 0.01),
        'g_norm_mix': gain(ks[10], (L, D_MODEL)),
        'w_in': nrm(ks[11], (L, D_MODEL, IN_COLS), D_MODEL ** -0.5),
        'g_q_a': gain(ks[12], (L, Q_LORA)),
        'w_q_b': nrm(ks[13], (L, Q_LORA, MLA_HEADS * (MLA_NOPE + MLA_ROPE)), Q_LORA ** -0.5),
        'g_kv_a': gain(ks[14], (L, KV_LORA)),
        'w_kv_b': nrm(ks[15], (L, KV_LORA, MLA_HEADS * (MLA_NOPE + MLA_V)), KV_LORA ** -0.5),
        'g_q_gqa': gain(ks[16], (L, GQA_HEAD_DIM)),
        'g_k_gqa': gain(ks[17], (L, GQA_HEAD_DIM)),
        'w_pool': nrm(ks[18], (L, len(POOL_WINDOWS), POOL_GROUP, POOL_GROUP), POOL_GROUP ** -0.5),
        'pool_scale': gain(ks[19], (L, POOL_WIDTH)),
        'w_br_a': nrm(ks[20], (L, MLA_OUT, D_MODEL), MLA_OUT ** -0.5),
        'w_br_b': nrm(ks[21], (L, GQA_OUT, D_MODEL), GQA_OUT ** -0.5),
        'w_br_c': nrm(ks[22], (L, POOL_WIDTH, D_MODEL), POOL_WIDTH ** -0.5),
        'w_out': nrm(ks[23], (L, D_MODEL, D_MODEL), D_MODEL ** -0.5),
        'g_norm_ffn': gain(ks[24], (L, D_MODEL)),
        'w_up': nrm(ks[25], (L, D_MODEL, 2 * D_FF), D_MODEL ** -0.5),
        'conv_w': nrm(ks[26], (L, 3, D_FF), 3 ** -0.5),
        'conv_b': nrm(ks[27], (L, D_FF), 0.01),
        'w_down': nrm(ks[28], (L, D_FF, D_MODEL), D_FF ** -0.5),
        'g_final': gain(ks[29], (D_MODEL,)),
    }


def reference(x_prompt, x_sample, c, cache_mla_ckv, cache_mla_krope, cache_gqa_k, cache_gqa_v,
              c_ctx, w_ada, b_ada, g_norm_mix, w_in, g_q_a, w_q_b, g_kv_a, w_kv_b, g_q_gqa, g_k_gqa,
              w_pool, pool_scale, w_br_a, w_br_b, w_br_c, w_out, g_norm_ffn, w_up, conv_w, conv_b,
              w_down, g_final):
    xp = x_prompt
    xs = x_sample
    st_ckv, st_krope, st_k, st_v = [], [], [], []
    for l in range(DEPTH):
        p = {
            'g_norm_mix': g_norm_mix[l], 'w_in': w_in[l], 'g_q_a': g_q_a[l], 'w_q_b': w_q_b[l],
            'g_kv_a': g_kv_a[l], 'w_kv_b': w_kv_b[l], 'g_q_gqa': g_q_gqa[l], 'g_k_gqa': g_k_gqa[l],
            'w_pool': w_pool[l], 'pool_scale': pool_scale[l], 'w_br_a': w_br_a[l], 'w_br_b': w_br_b[l],
            'w_br_c': w_br_c[l], 'w_out': w_out[l], 'g_norm_ffn': g_norm_ffn[l], 'w_up': w_up[l],
            'conv_w': conv_w[l], 'conv_b': conv_b[l], 'w_down': w_down[l],
        }
        mod_ctx = (jax.nn.silu(c_ctx) @ w_ada[l] + b_ada[l])[None, None, :]
        xp, st = trunk_layer(xp, mod_ctx, p)
        st_ckv.append(st[0])
        st_krope.append(st[1])
        st_k.append(st[2])
        st_v.append(st[3])
        mod_lat = (jax.nn.silu(c) @ w_ada[l] + b_ada[l])[:, None, :]
        xs, _ = trunk_layer(xs, mod_lat, p,
                            cache=(cache_mla_ckv[:, l], cache_mla_krope[:, l], cache_gqa_k[:, l], cache_gqa_v[:, l]))
    y_prompt = rms_norm(xp, g_final)
    y_sample = rms_norm(xs, g_final)
    new_mla_ckv = jnp.stack(st_ckv, axis=1)
    new_mla_krope = jnp.stack(st_krope, axis=1)
    new_gqa_k = jnp.stack(st_k, axis=1)
    new_gqa_v = jnp.stack(st_v, axis=1)
    return (y_prompt, y_sample, new_mla_ckv, new_mla_krope, new_gqa_k, new_gqa_v)
```

```cpp
#include <hip/hip_runtime.h>
#include <hip/hip_cooperative_groups.h>
#include <cstdio>
#include <cstdint>
namespace cg = cooperative_groups;

#ifndef PHASE_MASK
#define PHASE_MASK 0xFFFFFFFFu
#endif
#define PH(k) (((PHASE_MASK) >> (k)) & 1u)
#ifndef REPEAT_MASK
#define REPEAT_MASK 0u
#endif
#define NREP(k) (1 + (((REPEAT_MASK) >> (k)) & 1u))
#define RUNPH(k, ...) do { for (int rep_ = 0; rep_ < (int)NREP(k); ++rep_) { if (rep_) GRID_BAR(); __VA_ARGS__; } } while (0)
#ifndef USE_CG
#define USE_CG 0
#endif

#define LAS __attribute__((address_space(3)))
#define GAS __attribute__((address_space(1)))
typedef _Float16 f16;
typedef _Float16 h8 __attribute__((ext_vector_type(8)));
typedef _Float16 h4 __attribute__((ext_vector_type(4)));
typedef _Float16 h2 __attribute__((ext_vector_type(2)));
typedef float f32x2 __attribute__((ext_vector_type(2)));
typedef float f32x4 __attribute__((ext_vector_type(4)));
typedef float f32x16 __attribute__((ext_vector_type(16)));
typedef unsigned u32x2 __attribute__((ext_vector_type(2)));
typedef unsigned u32x4 __attribute__((ext_vector_type(4)));
typedef short s16x4 __attribute__((ext_vector_type(4)));

constexpr int DM = 1024, NTOK = 16384, NCTX = 8192, SEQC = 256, SEQL = 4096, PAST = 512, NKV = 17408, KVL = 4608;
constexpr int ZS = 1792, DFF = 2816, NMOD = 6144;
constexpr float RMS_EPS = 1e-6f;
constexpr float LOG2E = 1.4426950408889634f;
constexpr float SCALE_MLA = 0.10206207261596575f * LOG2E;
constexpr float SCALE_GQA = 0.125f * LOG2E;
constexpr int ZC_QA = 0, ZC_CKV = 256, ZC_KR = 384, ZC_GQ = 416, ZC_GK = 928, ZC_GV = 1056, ZC_PL = 1184, ZC_END = 1696;

constexpr size_t MiB = 1u << 20;
constexpr size_t WS_CTL = 0;
constexpr size_t CTL_ZERO_BYTES = 65536;
constexpr size_t CTL_MOD = 65536;
constexpr size_t CTL_TABM = CTL_MOD + 2 * 3 * 6144 * 4;
constexpr size_t CTL_TABG = CTL_TABM + 64 * 8 * 2 * 4;
constexpr size_t WS_W = 1 * MiB;
constexpr size_t WO_IN = 0;
constexpr size_t WO_G = WO_IN + (size_t)1792 * 1024 * 2;
constexpr size_t WO_QB = WO_G + (size_t)3072 * 1024 * 2;
constexpr size_t WO_KVB = WO_QB + (size_t)768 * 256 * 2;
constexpr size_t WO_POOL = WO_KVB + (size_t)1024 * 128 * 2;
constexpr size_t WO_BRAB = WO_POOL + (size_t)512 * 512 * 2;
constexpr size_t WO_BRC = WO_BRAB + (size_t)1024 * 1024 * 2;
constexpr size_t WO_OUT = WO_BRC + (size_t)1024 * 1024 * 2;
constexpr size_t WO_UP = WO_OUT + (size_t)1024 * 1024 * 2;
constexpr size_t WO_DOWN = WO_UP + (size_t)5632 * 1024 * 2;
constexpr size_t WL_BYTES = WO_DOWN + (size_t)1024 * 2816 * 2;
static_assert(WL_BYTES == 33 * MiB + MiB / 8, "weight map");
constexpr size_t WS_H = WS_W + 2 * WL_BYTES;
constexpr size_t WS_B = WS_H + 32 * MiB;
constexpr size_t WS_C = WS_B + 66 * MiB;
constexpr size_t WS_D = WS_C + 58 * MiB;
constexpr size_t WS_END = WS_D + 32 * MiB;
static_assert(WS_END <= 256 * MiB, "workspace");
constexpr size_t WS_ZS = WS_B;
constexpr size_t WS_KV = WS_B;
constexpr size_t WS_CO = WS_B + 34 * MiB;
constexpr size_t WS_GSCR = WS_B;
constexpr size_t WS_QA = WS_C;
constexpr size_t WS_PL = WS_C + 8 * MiB;
constexpr size_t WS_CKV = WS_C + 24 * MiB;
constexpr size_t WS_ABO = WS_C;
constexpr size_t WS_QG = WS_C + 32 * MiB;
constexpr size_t WS_KG = WS_C + 48 * MiB;
constexpr size_t WS_VG = WS_KG + (size_t)NKV * 128 * 2;
constexpr size_t WS_KR = WS_VG + (size_t)NKV * 128 * 2;
static_assert(WS_KR + (size_t)NKV * 32 * 2 <= WS_D, "region C");
constexpr size_t WS_QM = WS_D;
constexpr size_t WS_MERGED = WS_D;
constexpr size_t WS_ACT = WS_B;
constexpr size_t WS_EDGE = WS_B + 88 * MiB;
constexpr size_t WS_VEDGE = WS_EDGE + (size_t)256 * 4 * 2816 * 4;
static_assert(WS_VEDGE + (size_t)256 * 2 * 2816 * 4 <= WS_D, "ffn side buffers");

constexpr size_t OUT_Y = 0;
constexpr size_t OUT_CKV = (size_t)NTOK * DM;
constexpr size_t OUT_KR = OUT_CKV + (size_t)32 * 2 * 256 * 128;
constexpr size_t OUT_GK = OUT_KR + (size_t)32 * 2 * 256 * 32;
constexpr size_t OUT_GV = OUT_GK + (size_t)32 * 2 * 256 * 128;

constexpr int RING_BYTES = 131072;
constexpr int LDSCTL_OFF = RING_BYTES;
constexpr int LDS_BYTES = 147456;
constexpr int NWAVES = 8, NTHREADS = 512;

struct Params { const float* in[30]; float* out; unsigned char* ws; };

__device__ __forceinline__ float wave_sum(float v) {
#pragma unroll
    for (int o = 1; o < 64; o <<= 1) v += __shfl_xor(v, o);
    return v;
}
__device__ __forceinline__ unsigned pk2h(float lo, float hi) { h2 v; v.x = (f16)lo; v.y = (f16)hi; return __builtin_bit_cast(unsigned, v); }
__device__ __forceinline__ float h_lo(unsigned u) { h2 v = __builtin_bit_cast(h2, u); return (float)v.x; }
__device__ __forceinline__ float h_hi(unsigned u) { h2 v = __builtin_bit_cast(h2, u); return (float)v.y; }
__device__ __forceinline__ float fast_exp2(float x) { return __builtin_amdgcn_exp2f(x); }
__device__ __forceinline__ float sigmoidf_(float x) { return 1.0f / (1.0f + __expf(-x)); }
__device__ __forceinline__ float siluf_(float x) { return x / (1.0f + __expf(-x)); }
__device__ __forceinline__ int mod_class(int row) { return row < NCTX ? 0 : (row < NCTX + SEQL ? 1 : 2); }

namespace pg8 {
constexpr int BM = 256, BK = 64, HALF = 128, HTB = HALF * BK * 2, STAGE_BYTES = 8 * HTB, NXCD = 8, WGM = 8;
__host__ __device__ __forceinline__ int lds_byte(int r, int c) { const int st = (r >> 4) * 2 + (c >> 5), rr = r & 15, cc = c & 31, ob = rr * 64 + cc * 2; return st * 1024 + (ob ^ (((ob >> 9) & 1) << 5)); }
__host__ __device__ __forceinline__ void stage_rc(int b, int& R, int& C) { const int st = b / 1024, sb = b % 1024, swz = sb ^ (((sb >> 9) & 1) << 5); R = (st >> 1) * 16 + swz / 64; C = (st & 1) * 32 + (swz % 64) / 2; }
__host__ __device__ __forceinline__ int perm32(int rho) { const int n = rho >> 4, i = rho & 15; return 8 * (i >> 2) + 4 * n + (i & 3); }

struct Unit { const char* A; const char* B; int nt, pm, pn, mode; };

struct TileOrder {
    int nM, nN, nwg, G, c;
    __device__ void init(int nM_, int nN_, int G_, int c_) { nM = nM_; nN = nN_; nwg = nM * nN; G = G_; c = c_; }
    __device__ bool tile(int i, int& pm, int& pn) const {
        const long L = (long)i * G + c; if (L >= nwg) return false;
        int wgid = (int)L; { const int q = nwg / NXCD, r = nwg % NXCD, xcd = wgid % NXCD, off = wgid / NXCD; wgid = (xcd < r ? xcd * (q + 1) : r * (q + 1) + (xcd - r) * q) + off; }
        const int nig = WGM * nN, gid = wgid / nig, fm = gid * WGM, gsz = (nM - fm) < WGM ? (nM - fm) : WGM;
        pm = fm + ((wgid % nig) % gsz); pn = (wgid % nig) / gsz; return true;
    }
};

template <class Epi, class Sched, bool ALIGN_EPI>
__device__ __forceinline__ void gemm_phase(LAS unsigned char* lds, const int lda, const int ldb, const Sched& S, const Epi& E) {
    int tid_ = threadIdx.x; asm volatile("" : "+v"(tid_));
    const int tid = tid_, wid = __builtin_amdgcn_readfirstlane(tid >> 6), lane = tid & 63, wr = wid >> 2, wc = wid & 3, fr = lane & 15, fq = lane >> 4;
    unsigned voffA[2], voffB[2];
#pragma unroll
    for (int i = 0; i < 2; ++i) { int R, C; stage_rc(tid * 16 + i * 8192, R, C); const int Rb = Epi::PERM ? ((R & ~31) + perm32(R & 31)) : R;
        voffA[i] = (unsigned)(R * lda + C) * 2u; voffB[i] = (unsigned)(Rb * ldb + C) * 2u; }
    const size_t kstep = (size_t)(BK * 2);
    const size_t hstepA = (size_t)HALF * lda * 2, hstepB = (size_t)HALF * ldb * 2;
    const unsigned ldsw = (unsigned)wid * 1024u;
    const int aoff = lds_byte(wr * 64 + fr, fq * 8), boff = lds_byte(wc * 32 + fr, fq * 8);
#define PG8_SA(b, h) (((b) * 2 + (h)) * HTB)
#define PG8_SB(b, h) ((4 + (b) * 2 + (h)) * HTB)
#define PG8_STAGE(bufoff, gbase, voff) do { _Pragma("unroll") for (int _i = 0; _i < 2; ++_i) \
        __builtin_amdgcn_global_load_lds((const unsigned*)((const char*)(gbase) + (voff)[_i]), (LAS unsigned*)(lds + (bufoff) + ldsw + _i * 8192), 16, 0, 0); } while (0)
#define PG8_LDA(dst, b, h) do { _Pragma("unroll") for (int m = 0; m < 4; ++m) _Pragma("unroll") for (int k = 0; k < 2; ++k) dst[m][k] = *(const LAS h8*)(lds + PG8_SA(b, h) + aoff + m * 2048 + k * 1024); } while (0)
#define PG8_LDB(dst, b, h) do { _Pragma("unroll") for (int n = 0; n < 2; ++n) _Pragma("unroll") for (int k = 0; k < 2; ++k) dst[n][k] = *(const LAS h8*)(lds + PG8_SB(b, h) + boff + n * 2048 + k * 1024); } while (0)
#define PG8_MMA(ai, bj, At, Bt) do { __builtin_amdgcn_s_setprio(1); _Pragma("unroll") for (int m = 0; m < 4; ++m) _Pragma("unroll") for (int n = 0; n < 2; ++n) _Pragma("unroll") for (int k = 0; k < 2; ++k) \
        acc[ai][bj][m][n] = __builtin_amdgcn_mfma_f32_16x16x32_f16(Bt[n][k], At[m][k], acc[ai][bj][m][n], 0, 0, 0); __builtin_amdgcn_s_setprio(0); } while (0)
#define PG8_WAIT_V(n) asm volatile("s_waitcnt vmcnt(" #n ")" ::: "memory")
#define PG8_WAIT_L(n) asm volatile("s_waitcnt lgkmcnt(" #n ")" ::: "memory")
#define PG8_BAR __builtin_amdgcn_s_barrier()
#define PG8_SCHED __builtin_amdgcn_sched_barrier(0)
    Unit cur, nxt; int ui = 0;
    if (!S.next(0, cur)) return;
    f32x4 acc[2][2][4][2];
#pragma unroll
    for (int a = 0; a < 2; ++a)
#pragma unroll
        for (int b = 0; b < 2; ++b)
#pragma unroll
            for (int m = 0; m < 4; ++m)
#pragma unroll
                for (int n = 0; n < 2; ++n) acc[a][b][m][n] = (f32x4){0.f, 0.f, 0.f, 0.f};
    h8 At[4][2], B0[2][2], B1[2][2];
    const char* cA = cur.A; const char* cB = cur.B;
    PG8_STAGE(PG8_SB(0, 0), cB, voffB); PG8_STAGE(PG8_SB(0, 1), cB + hstepB, voffB); PG8_STAGE(PG8_SA(0, 0), cA, voffA); PG8_STAGE(PG8_SA(0, 1), cA + hstepA, voffA);
    if (wr == 1) PG8_BAR;
    PG8_WAIT_V(2); PG8_BAR;
    PG8_STAGE(PG8_SB(1, 0), cB + kstep, voffB); PG8_STAGE(PG8_SA(1, 0), cA + kstep, voffA); PG8_STAGE(PG8_SB(1, 1), cB + hstepB + kstep, voffB);
    PG8_WAIT_V(6); PG8_BAR;
    for (;;) {
        const bool has_next = S.next(ui + 1, nxt);
        const char* nA = has_next ? nxt.A : cA; const char* nB = has_next ? nxt.B : cB;
        const int nt = cur.nt;
        for (int t = 0; t < nt; t += 2) {
            const bool last = (t == nt - 2);
            const char* a1 = cA + (size_t)(t + 1) * kstep;
            const char* a2 = last ? nA : cA + (size_t)(t + 2) * kstep; const char* b2 = last ? nB : cB + (size_t)(t + 2) * kstep;
            const char* a3 = a2 + kstep; const char* b3 = b2 + kstep;
            PG8_LDB(B0, 0, 0); PG8_LDB(B1, 0, 1); PG8_SCHED; PG8_LDA(At, 0, 0); PG8_STAGE(PG8_SA(1, 1), a1 + hstepA, voffA);
            PG8_WAIT_V(8); PG8_WAIT_L(0); PG8_BAR; PG8_MMA(0, 0, At, B0); PG8_MMA(0, 1, At, B1); PG8_BAR; PG8_SCHED;
            PG8_LDA(At, 0, 1); PG8_STAGE(PG8_SB(0, 0), b2, voffB); PG8_STAGE(PG8_SB(0, 1), b2 + hstepB, voffB); PG8_STAGE(PG8_SA(0, 0), a2, voffA);
            PG8_WAIT_V(8); PG8_WAIT_L(0); PG8_BAR; PG8_MMA(1, 0, At, B0); PG8_MMA(1, 1, At, B1); PG8_BAR; PG8_SCHED;
            PG8_LDB(B0, 1, 0); PG8_LDB(B1, 1, 1); PG8_SCHED; PG8_LDA(At, 1, 0); PG8_STAGE(PG8_SA(0, 1), a2 + hstepA, voffA);
            PG8_WAIT_V(8); PG8_WAIT_L(0); PG8_BAR; PG8_MMA(0, 0, At, B0); PG8_MMA(0, 1, At, B1); PG8_BAR; PG8_SCHED;
            PG8_LDA(At, 1, 1); PG8_STAGE(PG8_SB(1, 0), b3, voffB); PG8_STAGE(PG8_SB(1, 1), b3 + hstepB, voffB); PG8_STAGE(PG8_SA(1, 0), a3, voffA);
            PG8_WAIT_V(8); PG8_WAIT_L(0); PG8_BAR; PG8_MMA(1, 0, At, B0); PG8_MMA(1, 1, At, B1); PG8_BAR; PG8_SCHED;
        }
        if constexpr (ALIGN_EPI) { if (wr == 0) PG8_BAR; }
        E(acc, cur, wr, wc, fr, fq);
        if (!has_next) break;
#pragma unroll
        for (int a = 0; a < 2; ++a)
#pragma unroll
            for (int b = 0; b < 2; ++b)
#pragma unroll
                for (int m = 0; m < 4; ++m)
#pragma unroll
                    for (int n = 0; n < 2; ++n) acc[a][b][m][n] = (f32x4){0.f, 0.f, 0.f, 0.f};
        cur = nxt; cA = nA; cB = nB; ++ui;
        if constexpr (ALIGN_EPI) { if (wr == 1) PG8_BAR; }
    }
    PG8_WAIT_V(0);
    if constexpr (!ALIGN_EPI) { if (wr == 0) PG8_BAR; }
    PG8_BAR;
#undef PG8_SA
#undef PG8_SB
#undef PG8_STAGE
#undef PG8_LDA
#undef PG8_LDB
#undef PG8_MMA
#undef PG8_WAIT_V
#undef PG8_WAIT_L
#undef PG8_BAR
#undef PG8_SCHED
}

struct EpiF16 {
    static constexpr bool PERM = true;
    f16* O; int ldc; int mode; const float* aux; float scale;
    __device__ __forceinline__ void operator()(const f32x4 (&acc)[2][2][4][2], const Unit& u, int wr, int wc, int fr, int fq) const {
        const int row0 = u.pm * BM + wr * 64 + fr;
#pragma unroll
        for (int bj = 0; bj < 2; ++bj) {
            const int cg32 = u.pn * BM + bj * HALF + wc * 32;
            const int col0 = cg32 + 8 * fq;
            const bool rope = (mode == 1) && ((cg32 % 96) == 64) && (u.pm >= 32);
            float cs[8];
            if (mode == 2) {
#pragma unroll
                for (int e = 0; e < 8; ++e) cs[e] = aux[col0 + e];
            }
#pragma unroll
            for (int ai = 0; ai < 2; ++ai)
#pragma unroll
                for (int m = 0; m < 4; ++m) {
                    const int row = row0 + ai * HALF + m * 16;
                    float v[8];
#pragma unroll
                    for (int n = 0; n < 2; ++n)
#pragma unroll
                        for (int e = 0; e < 4; ++e) v[4 * n + e] = acc[ai][bj][m][n][e];
                    if (mode == 1) {
                        if (rope) {
                            const int t = (row - NCTX) & (SEQL - 1);
                            const int pos = (fq < 2) ? (t >> 6) : (t & 63);
                            const float* tb = aux + pos * 16;
#pragma unroll
                            for (int e = 0; e < 8; ++e) {
                                const float other = __shfl_xor(v[e], 16);
                                const float c = tb[2 * e], s = tb[2 * e + 1];
                                v[e] = (fq & 1) ? (other * s + v[e] * c) : (v[e] * c - other * s);
                            }
                        }
#pragma unroll
                        for (int e = 0; e < 8; ++e) v[e] *= scale;
                    } else if (mode == 2) {
#pragma unroll
                        for (int e = 0; e < 8; ++e) v[e] *= cs[e];
                    }
                    u32x4 w; w.x = pk2h(v[0], v[1]); w.y = pk2h(v[2], v[3]); w.z = pk2h(v[4], v[5]); w.w = pk2h(v[6], v[7]);
                    *(u32x4*)(O + (size_t)row * ldc + col0) = w;
                }
        }
    }
};

struct EpiMerge {
    static constexpr bool PERM = true;
    unsigned char* scr; f16* merged;
    __device__ __forceinline__ void operator()(const f32x4 (&acc)[2][2][4][2], const Unit& u, int wr, int wc, int fr, int fq) const {
        int tid = (wr * 4 + wc) * 64 + fq * 16 + fr; asm volatile("" : "+v"(tid));
        const int row0 = u.pm * BM + wr * 64 + fr;
#pragma unroll
        for (int ai = 0; ai < 2; ++ai)
#pragma unroll
            for (int bj = 0; bj < 2; ++bj)
#pragma unroll
                for (int m = 0; m < 4; ++m) {
                    const int idx = (ai * 2 + bj) * 4 + m;
                    u32x4* sp = (u32x4*)(scr + ((size_t)idx * NTHREADS + tid) * 16);
                    float v[8];
#pragma unroll
                    for (int n = 0; n < 2; ++n)
#pragma unroll
                        for (int e = 0; e < 4; ++e) v[4 * n + e] = acc[ai][bj][m][n][e];
                    if ((u.mode & 1) == 0) {
#pragma unroll
                        for (int e = 0; e < 8; ++e) v[e] = sigmoidf_(v[e]);
                        u32x4 w; w.x = pk2h(v[0], v[1]); w.y = pk2h(v[2], v[3]); w.z = pk2h(v[4], v[5]); w.w = pk2h(v[6], v[7]);
                        *sp = w;
                    } else {
                        const u32x4 g = *sp;
                        v[0] *= h_lo(g.x); v[1] *= h_hi(g.x); v[2] *= h_lo(g.y); v[3] *= h_hi(g.y); v[4] *= h_lo(g.z); v[5] *= h_hi(g.z); v[6] *= h_lo(g.w); v[7] *= h_hi(g.w);
                        const int row = row0 + ai * HALF + m * 16, col0 = u.pn * BM + bj * HALF + wc * 32 + 8 * fq;
                        u32x4* mp = (u32x4*)(merged + (size_t)row * DM + col0);
                        if (u.mode != 1) {
                            const u32x4 o = *mp;
                            v[0] += h_lo(o.x); v[1] += h_hi(o.x); v[2] += h_lo(o.y); v[3] += h_hi(o.y); v[4] += h_lo(o.z); v[5] += h_hi(o.z); v[6] += h_lo(o.w); v[7] += h_hi(o.w);
                        }
                        u32x4 w; w.x = pk2h(v[0], v[1]); w.y = pk2h(v[2], v[3]); w.z = pk2h(v[4], v[5]); w.w = pk2h(v[6], v[7]);
                        *mp = w;
                    }
                }
    }
};

struct EpiRes {
    static constexpr bool PERM = false;
    const float* srcP; const float* srcS;
    float* out; const float* gate;
    __device__ __forceinline__ void operator()(const f32x4 (&acc)[2][2][4][2], const Unit& u, int wr, int wc, int fr, int fq) const {
        const int cls = u.pm < 32 ? 0 : (u.pm < 48 ? 1 : 2);
        const float* src = u.pm < 32 ? srcP + (size_t)u.pm * BM * DM : srcS + (size_t)(u.pm - 32) * BM * DM;
        float* dst = out + (size_t)u.pm * BM * DM;
        const int col0 = u.pn * BM + wc * 32 + 4 * fq;
#pragma unroll
        for (int bj = 0; bj < 2; ++bj)
#pragma unroll
            for (int n = 0; n < 2; ++n) {
                const int col = col0 + bj * HALF + n * 16;
                const f32x4 gv = *(const f32x4*)(gate + cls * NMOD + col);
#pragma unroll
                for (int ai = 0; ai < 2; ++ai)
#pragma unroll
                    for (int m = 0; m < 4; ++m) {
                        const size_t off = (size_t)(ai * HALF + wr * 64 + m * 16 + fr) * DM + col;
                        const f32x4 s = *(const f32x4*)(src + off);
                        *(f32x4*)(dst + off) = s + gv * acc[ai][bj][m][n];
                    }
            }
    }
};

struct EpiUp {
    static constexpr bool PERM = true;
    f16* act; float* edge; float* vedge; const float* convw; const float* convb;
    __device__ __forceinline__ void operator()(const f32x4 (&acc)[2][2][4][2], const Unit& u, int wr, int wc, int fr, int fq) const {
        const int lane = fq * 16 + fr;
        const int j0 = u.pn * 128 + wc * 32 + 8 * fq;
        const int src_prev = (lane & ~15) | ((fr + 15) & 15), src_next = (lane & ~15) | ((fr + 1) & 15);
#pragma unroll
        for (int n = 0; n < 2; ++n) {
            const f32x4 w0 = *(const f32x4*)(convw + j0 + 4 * n), w1 = *(const f32x4*)(convw + DFF + j0 + 4 * n), w2 = *(const f32x4*)(convw + 2 * DFF + j0 + 4 * n), cb = *(const f32x4*)(convb + j0 + 4 * n);
#pragma unroll
            for (int ai = 0; ai < 2; ++ai) {
                const int chunk = u.pm * 4 + ai * 2 + wr;
                const int rowc = u.pm * BM + ai * HALF + wr * 64;
#pragma unroll
                for (int m = 0; m < 4; ++m) {
                    const f32x4 cur = acc[ai][0][m][n], val = acc[ai][1][m][n];
                    const f32x4 up = acc[ai][0][m > 0 ? m - 1 : 0][n], dn = acc[ai][0][m < 3 ? m + 1 : 3][n];
                    f32x4 pv, nv;
#pragma unroll
                    for (int e = 0; e < 4; ++e) {
                        const float selp = (fr == 15) ? up[e] : cur[e];
                        const float seln = (fr == 0) ? dn[e] : cur[e];
                        pv[e] = __shfl(selp, src_prev); nv[e] = __shfl(seln, src_next);
                    }
                    const int i = m * 16 + fr;
                    const int row = rowc + i;
                    f32x4 g = w0 * pv + w1 * cur + w2 * nv + cb;
                    float a[4];
#pragma unroll
                    for (int e = 0; e < 4; ++e) a[e] = siluf_(g[e]) * val[e];
                    if (i != 0 && i != 63) {
                        u32x2 w; w.x = pk2h(a[0], a[1]); w.y = pk2h(a[2], a[3]);
                        *(u32x2*)(act + (size_t)row * DFF + j0 + 4 * n) = w;
                    }
                    if (m == 0 && fr < 2) *(f32x4*)(edge + ((size_t)chunk * 4 + fr) * DFF + j0 + 4 * n) = cur;
                    if (m == 3 && fr >= 14) *(f32x4*)(edge + ((size_t)chunk * 4 + (fr - 12)) * DFF + j0 + 4 * n) = cur;
                    if (m == 0 && fr == 0) *(f32x4*)(vedge + ((size_t)chunk * 2 + 0) * DFF + j0 + 4 * n) = val;
                    if (m == 3 && fr == 15) *(f32x4*)(vedge + ((size_t)chunk * 2 + 1) * DFF + j0 + 4 * n) = val;
                }
            }
        }
    }
};

struct SchedPlain {
    TileOrder T; const char* A; const char* B; int lda, ldb, nt, koff;
    __device__ __forceinline__ bool next(int i, Unit& u) const {
        int pm, pn; if (!T.tile(i, pm, pn)) return false;
        u.A = A + ((size_t)pm * BM * lda + (size_t)pn * koff) * 2; u.B = B + ((size_t)pn * BM * ldb + (size_t)pn * koff) * 2; u.nt = nt; u.pm = pm; u.pn = pn; u.mode = 0; return true;
    }
};
struct SchedMerge {
    TileOrder T; const char* Hh; const char* ABO; const char* CO; const char* Wg; const char* Wab; const char* Wc;
    __device__ __forceinline__ bool next(int i, Unit& u) const {
        int pm, pn; if (!T.tile(i / 6, pm, pn)) return false;
        const int sub = i % 6, br = sub >> 1;
        u.pm = pm; u.pn = pn; u.mode = sub;
        if ((sub & 1) == 0) { u.A = Hh + (size_t)pm * BM * 1024 * 2; u.B = Wg + ((size_t)(br * 1024 + pn * BM) * 1024) * 2; u.nt = 16; }
        else if (br < 2)    { u.A = ABO + ((size_t)pm * BM * 1024 + br * 512) * 2; u.B = Wab + ((size_t)pn * BM * 1024 + br * 512) * 2; u.nt = 8; }
        else                { u.A = CO + (size_t)pm * BM * 1024 * 2; u.B = Wc + (size_t)pn * BM * 1024 * 2; u.nt = 8; }
        return true;
    }
};
}

namespace attn {
constexpr int NSLOT = 3, A_KSZ = 12288, A_VSZ = 8192, A_K0 = 0, A_V0 = NSLOT * A_KSZ, A_WSF = A_V0 + NSLOT * A_VSZ, A_OST = A_WSF + 2048, A_END = A_OST + 8 * 4096;
static_assert(A_END <= RING_BYTES, "attention LDS");
constexpr float THR = 6.0f;
__device__ __forceinline__ int crow(int r, int hi) { return (r & 3) + 8 * (r >> 2) + 4 * hi; }

struct Src { const f16* K1; int k1p; const f16* K2; int k2p; const f16* V; int vp; };

#define AT_WAIT(n) asm volatile("s_waitcnt vmcnt(" #n ")" ::: "memory")
template <int DQK>
__device__ __forceinline__ void unit(LAS unsigned char* lds, const f16* Q, int qp, const Src s, int ntiles, f16* O, int op) {
    constexpr int ND = DQK / 16;
    int tid_ = threadIdx.x; asm volatile("" : "+v"(tid_));
    const int tid = tid_, lane = tid & 63, r32 = lane & 31, hi = lane >> 5;
    const int wid = __builtin_amdgcn_readfirstlane(tid >> 6);
    LAS float* wsf = (LAS float*)(lds + A_WSF) + wid * 64;
    const f16* ksrc = s.K1 + (size_t)lane * s.k1p + wid * 8;
    const f16* k2src = (DQK == 96) ? s.K2 + (size_t)lane * s.k2p + (wid & 3) * 8 : nullptr;
    const f16* vsrc = s.V + (size_t)(16 * (wid & 3) + (lane >> 2)) * s.vp + (wid >> 2) * 32 + (lane & 3) * 8;
    const size_t kst = (size_t)64 * s.k1p, k2st = (size_t)64 * s.k2p, vst = (size_t)64 * s.vp;
    const bool rope_w = (DQK == 96) && (wid < 4);
#define AT_DMA(t, slot) do { \
        __builtin_amdgcn_global_load_lds((const unsigned*)(ksrc + (size_t)(t) * kst), (LAS unsigned*)(lds + A_K0 + (slot) * A_KSZ + wid * 1024), 16, 0, 0); \
        if (rope_w) __builtin_amdgcn_global_load_lds((const unsigned*)(k2src + (size_t)(t) * k2st), (LAS unsigned*)(lds + A_K0 + (slot) * A_KSZ + (8 + wid) * 1024), 16, 0, 0); \
        __builtin_amdgcn_global_load_lds((const unsigned*)(vsrc + (size_t)(t) * vst), (LAS unsigned*)(lds + A_V0 + (slot) * A_VSZ + wid * 1024), 16, 0, 0); } while (0)
    h8 qf[ND];
    { const f16* qw = Q + (size_t)(wid * 32 + r32) * qp + hi * 8;
#pragma unroll
      for (int d0 = 0; d0 < ND; ++d0) qf[d0] = *(const h8*)(qw + d0 * 16); }
    AT_DMA(0, 0);
    if (ntiles > 1) AT_DMA(1, 1);
    float m_run = -1e30f, l_run = 0.f;
    f32x16 o0 = {}, o1 = {};
    const int vrd = ((lane >> 4) & 1) * 32 + (lane & 3) * 8 + (4 * hi + ((lane & 15) >> 2)) * 64;
    int slot = 0;
    for (int t = 0; t < ntiles; ++t) {
        if (t + 1 < ntiles) { if (rope_w) AT_WAIT(3); else AT_WAIT(2); } else AT_WAIT(0);
        __builtin_amdgcn_s_barrier();
        asm volatile("" ::: "memory");
        if (t + 2 < ntiles) { const int s2 = slot == 0 ? 2 : slot - 1; AT_DMA(t + 2, s2); }
        const int kb = A_K0 + slot * A_KSZ, vb = A_V0 + slot * A_VSZ;
        f32x16 p0 = {}, p1 = {};
        { const LAS unsigned char* kp = lds + kb + hi * 1024 + r32 * 16;
#pragma unroll
          for (int d0 = 0; d0 < ND; ++d0) {
              const h8 k0 = *(const LAS h8*)(kp + d0 * 2048), k1 = *(const LAS h8*)(kp + d0 * 2048 + 512);
              p0 = __builtin_amdgcn_mfma_f32_32x32x16_f16(k0, qf[d0], p0, 0, 0, 0);
              p1 = __builtin_amdgcn_mfma_f32_32x32x16_f16(k1, qf[d0], p1, 0, 0, 0);
          } }
        float mt = fmaxf(p0[0], p1[0]);
#pragma unroll
        for (int r = 1; r < 16; ++r) mt = fmaxf(mt, fmaxf(p0[r], p1[r]));
        mt = fmaxf(mt, __shfl_xor(mt, 32));
        if (__any(mt > m_run + THR)) {
            const float mn = (mt > m_run + THR) ? mt : m_run, alpha = fast_exp2(m_run - mn);
            l_run *= alpha; m_run = mn;
            if (hi == 0) wsf[r32] = alpha;
            __builtin_amdgcn_wave_barrier();
#pragma unroll
            for (int r = 0; r < 16; ++r) { const float a = wsf[crow(r, hi)]; o0[r] *= a; o1[r] *= a; }
            __builtin_amdgcn_wave_barrier();
        }
        float ls = 0.f;
#pragma unroll
        for (int r = 0; r < 16; ++r) { p0[r] = fast_exp2(p0[r] - m_run); p1[r] = fast_exp2(p1[r] - m_run); ls += p0[r] + p1[r]; }
        l_run += ls;
        u32x4 pw[4];
#pragma unroll
        for (int q = 0; q < 2; ++q) {
            pw[q] = (u32x4){pk2h(p0[8 * q], p0[8 * q + 1]), pk2h(p0[8 * q + 2], p0[8 * q + 3]), pk2h(p0[8 * q + 4], p0[8 * q + 5]), pk2h(p0[8 * q + 6], p0[8 * q + 7])};
            pw[2 + q] = (u32x4){pk2h(p1[8 * q], p1[8 * q + 1]), pk2h(p1[8 * q + 2], p1[8 * q + 3]), pk2h(p1[8 * q + 4], p1[8 * q + 5]), pk2h(p1[8 * q + 6], p1[8 * q + 7])};
        }
        { const LAS unsigned char* vp = lds + vb + vrd;
#pragma unroll
          for (int ks = 0; ks < 4; ++ks) {
              const s16x4 a0 = __builtin_amdgcn_ds_read_tr16_b64_v4i16((LAS s16x4*)(vp + ks * 1024));
              const s16x4 a1 = __builtin_amdgcn_ds_read_tr16_b64_v4i16((LAS s16x4*)(vp + ks * 1024 + 512));
              const s16x4 b0 = __builtin_amdgcn_ds_read_tr16_b64_v4i16((LAS s16x4*)(vp + 4096 + ks * 1024));
              const s16x4 b1 = __builtin_amdgcn_ds_read_tr16_b64_v4i16((LAS s16x4*)(vp + 4096 + ks * 1024 + 512));
              typedef short s16x8 __attribute__((ext_vector_type(8)));
              const s16x8 va = {a0[0], a0[1], a0[2], a0[3], a1[0], a1[1], a1[2], a1[3]};
              const s16x8 vb8 = {b0[0], b0[1], b0[2], b0[3], b1[0], b1[1], b1[2], b1[3]};
              const h8 pa = __builtin_bit_cast(h8, pw[ks]);
              o0 = __builtin_amdgcn_mfma_f32_32x32x16_f16(pa, __builtin_bit_cast(h8, va), o0, 0, 0, 0);
              o1 = __builtin_amdgcn_mfma_f32_32x32x16_f16(pa, __builtin_bit_cast(h8, vb8), o1, 0, 0, 0);
          } }
        slot = slot == 2 ? 0 : slot + 1;
    }
    l_run += __shfl_xor(l_run, 32);
    if (hi == 0) wsf[32 + r32] = l_run;
    __builtin_amdgcn_wave_barrier();
    LAS f16* stg = (LAS f16*)(lds + A_OST) + wid * 2048;
#pragma unroll
    for (int r = 0; r < 16; ++r) {
        const int orow = crow(r, hi); const float rl = 1.0f / wsf[32 + orow];
        stg[orow * 64 + r32] = (f16)(o0[r] * rl); stg[orow * 64 + 32 + r32] = (f16)(o1[r] * rl);
    }
    __builtin_amdgcn_wave_barrier();
    f16* ow = O + (size_t)(wid * 32) * op;
#pragma unroll
    for (int i = 0; i < 4; ++i) { const int row = i * 8 + (lane >> 3), ch = lane & 7; const u32x4 v = *(const LAS u32x4*)(stg + row * 64 + ch * 8); *(u32x4*)(ow + (size_t)row * op + ch * 8) = v; }
    asm volatile("s_waitcnt lgkmcnt(0)" ::: "memory");
    __builtin_amdgcn_s_barrier();
    asm volatile("" ::: "memory");
#undef AT_DMA
}
#undef AT_WAIT
}

struct Frame {
    LAS unsigned char* lds;
    int tid, lane, wave, vcu, G;
    unsigned char* ws; float* out;
};

#if !USE_CG
#define XB_TMO      128
#define XB_XCNT(j)  (256  + 64 * (j))
#define XB_XSUB(j)  (1280 + 64 * (j))
#define XB_XGEN(j)  (2304 + 64 * (j))
#define XB_TOP      3328
#define XB_TOPGEN   3392
#define XCD_BAR_WORDS 3456
#define XB_SPIN_CAP (1u << 18)
__device__ __forceinline__ unsigned xb_ld(unsigned* p)              { return __hip_atomic_load(p, __ATOMIC_RELAXED, __HIP_MEMORY_SCOPE_AGENT); }
__device__ __forceinline__ unsigned xb_add(unsigned* p, unsigned v) { return __hip_atomic_fetch_add(p, v, __ATOMIC_RELAXED, __HIP_MEMORY_SCOPE_AGENT); }
__device__ __forceinline__ unsigned xb_xcc_id() { return (unsigned)__builtin_amdgcn_s_getreg((3 << 11) | 20) & 0xFu; }
#define XB_SPIN(cond, bar) do { unsigned _sp = 0; while (cond) { __builtin_amdgcn_s_sleep(1); \
    if ((++_sp & 255u) == 0u) { if (xb_ld(&(bar)[XB_TMO])) break; if (_sp > XB_SPIN_CAP) { atomicAdd(&(bar)[XB_TMO], 1u); break; } } } } while (0)
struct XcdBarrier { unsigned* bar; unsigned x; volatile LAS unsigned* st; };
__device__ __forceinline__ XcdBarrier xcd_barrier_post(unsigned* bar, volatile LAS unsigned* st) {
    XcdBarrier b; b.bar = bar; b.x = xb_xcc_id(); b.st = st;
    if (threadIdx.x == 0) (void)xb_add(&bar[XB_XCNT(b.x)], 1u);
    return b;
}
__device__ __forceinline__ void xcd_barrier_complete(unsigned* bar, unsigned x, unsigned& nloc, unsigned& nx) {
    const unsigned G = gridDim.x * gridDim.y * gridDim.z;
    unsigned sum, cnt, mine, sp = 0u;
    for (;;) {
        sum = 0u; cnt = 0u; mine = 0u;
#pragma unroll
        for (unsigned j = 0; j < 16; ++j) { const unsigned c = xb_ld(&bar[XB_XCNT(j)]); sum += c; cnt += (c > 0u) ? 1u : 0u; mine = (j == x) ? c : mine; }
        if (sum == G) break;
        __builtin_amdgcn_s_sleep(1);
        if ((++sp & 255u) == 0u) { if (xb_ld(&bar[XB_TMO])) break; if (sp > XB_SPIN_CAP) { atomicAdd(&bar[XB_TMO], 1u); break; } }
    }
    nloc = mine > 0u ? mine : 1u; nx = cnt > 0u ? cnt : 1u;
}
__device__ __forceinline__ void xcd_barrier(const XcdBarrier& b) {
    asm volatile("s_waitcnt vmcnt(0)" ::: "memory");
    __syncthreads();
    if (threadIdx.x == 0) {
        unsigned* bar = b.bar;
        __builtin_amdgcn_s_waitcnt(0);
        unsigned nloc = b.st[0], nx = b.st[1];
        if (nloc == 0u) { xcd_barrier_complete(bar, b.x, nloc, nx); b.st[0] = nloc; b.st[1] = nx; }
        const unsigned old = xb_add(&bar[XB_XSUB(b.x)], 1u);
        const unsigned gen = old / nloc;
        if (old + 1u == (gen + 1u) * nloc) {
            __builtin_amdgcn_fence(__ATOMIC_RELEASE, "agent");
            asm volatile("s_waitcnt vmcnt(0)" ::: "memory");
            const unsigned og = xb_add(&bar[XB_TOP], 1u);
            const unsigned tg = og / nx;
            if (og + 1u == (tg + 1u) * nx) xb_add(&bar[XB_TOPGEN], 1u);
            else XB_SPIN(xb_ld(&bar[XB_TOPGEN]) == tg, bar);
            __builtin_amdgcn_fence(__ATOMIC_ACQUIRE, "agent");
            xb_add(&bar[XB_XGEN(b.x)], 1u);
            asm volatile("s_waitcnt vmcnt(0)" ::: "memory");
        } else {
            XB_SPIN(xb_ld(&bar[XB_XGEN(b.x)]) == gen, bar);
            __builtin_amdgcn_fence(__ATOMIC_ACQUIRE, "agent");
            asm volatile("s_waitcnt vmcnt(0)" ::: "memory");
        }
    }
    __syncthreads();
}
#endif

__device__ __forceinline__ void transpose_item(const float* W, int N, f16* WT, int dpitch, int drow0, int koff, LAS float* scr, int k0, int n0, int lane) {
#pragma unroll 8
    for (int i = 0; i < 32; ++i) { const int kk = 2 * i + (lane >> 5); scr[kk * 33 + (lane & 31)] = W[(size_t)(k0 + kk) * N + n0 + (lane & 31)]; }
    asm volatile("s_waitcnt lgkmcnt(0)" ::: "memory");
    const int c = lane & 7;
#pragma unroll
    for (int j = 0; j < 4; ++j) { const int n = (lane >> 3) + 8 * j; const LAS float* s = scr + (8 * c) * 33 + n;
        u32x4 o; o.x = pk2h(s[0 * 33], s[1 * 33]); o.y = pk2h(s[2 * 33], s[3 * 33]); o.z = pk2h(s[4 * 33], s[5 * 33]); o.w = pk2h(s[6 * 33], s[7 * 33]);
        *(u32x4*)(WT + (size_t)(drow0 + n) * dpitch + koff + k0 + 8 * c) = o; }
    asm volatile("s_waitcnt lgkmcnt(0)" ::: "memory");
}

constexpr int IT_IN = 16 * 53, IT_G = 16 * 96, IT_QB = 4 * 24, IT_KVB = 2 * 32, IT_POOL = 4 * 2 * 4, IT_BRA = 8 * 32, IT_BRB = 8 * 32, IT_BRC = 8 * 32, IT_OUT = 16 * 32, IT_UP = 16 * 176, IT_DOWN = 44 * 32;
constexpr int IT_LAYER = IT_IN + IT_G + IT_QB + IT_KVB + IT_POOL + IT_BRA + IT_BRB + IT_BRC + IT_OUT + IT_UP + IT_DOWN;

__device__ __forceinline__ void p0_convert(const Frame& F_, const Params& p) {
    Frame F = F_; { int t_ = threadIdx.x; asm volatile("" : "+v"(t_)); F.tid = t_; F.lane = t_ & 63; F.wave = __builtin_amdgcn_readfirstlane(t_ >> 6); }
    LAS float* scr = (LAS float*)(F.lds + F.wave * 16384);
    const int gw = F.vcu * NWAVES + F.wave, NGW = F.G * NWAVES;
    for (int it = gw; it < 2 * IT_LAYER; it += NGW) {
        const int l = it / IT_LAYER; int r = it % IT_LAYER;
        unsigned char* wl = F.ws + WS_W + (size_t)l * WL_BYTES;
        if (r < IT_IN) { const int kb = r / 53, nb = r % 53; transpose_item(p.in[11] + (size_t)l * 1024 * 4768, 4768, (f16*)(wl + WO_IN), 1024, 32 * nb, 0, scr, 64 * kb, 32 * nb, F.lane); continue; } r -= IT_IN;
        if (r < IT_G) { const int kb = r / 96, nb = r % 96; transpose_item(p.in[11] + (size_t)l * 1024 * 4768, 4768, (f16*)(wl + WO_G), 1024, 32 * nb, 0, scr, 64 * kb, 1696 + 32 * nb, F.lane); continue; } r -= IT_G;
        if (r < IT_QB) { const int kb = r / 24, nb = r % 24; transpose_item(p.in[13] + (size_t)l * 256 * 768, 768, (f16*)(wl + WO_QB), 256, 32 * nb, 0, scr, 64 * kb, 32 * nb, F.lane); continue; } r -= IT_QB;
        if (r < IT_KVB) { const int kb = r / 32, nb = r % 32; transpose_item(p.in[15] + (size_t)l * 128 * 1024, 1024, (f16*)(wl + WO_KVB), 128, 32 * nb, 0, scr, 64 * kb, 32 * nb, F.lane); continue; } r -= IT_KVB;
        if (r < IT_POOL) { const int g = r / 8, kb = (r % 8) / 4, nb = r % 4; transpose_item(p.in[18] + ((size_t)l * 4 + g) * 128 * 128, 128, (f16*)(wl + WO_POOL), 512, g * 128 + 32 * nb, g * 128, scr, 64 * kb, 32 * nb, F.lane); continue; } r -= IT_POOL;
        if (r < IT_BRA) { const int kb = r / 32, nb = r % 32; transpose_item(p.in[20] + (size_t)l * 512 * 1024, 1024, (f16*)(wl + WO_BRAB), 1024, 32 * nb, 0, scr, 64 * kb, 32 * nb, F.lane); continue; } r -= IT_BRA;
        if (r < IT_BRB) { const int kb = r / 32, nb = r % 32; transpose_item(p.in[21] + (size_t)l * 512 * 1024, 1024, (f16*)(wl + WO_BRAB), 1024, 32 * nb, 512, scr, 64 * kb, 32 * nb, F.lane); continue; } r -= IT_BRB;
        if (r < IT_BRC) { const int kb = r / 32, nb = r % 32; transpose_item(p.in[22] + (size_t)l * 512 * 1024, 1024, (f16*)(wl + WO_BRC), 1024, 32 * nb, 0, scr, 64 * kb, 32 * nb, F.lane); continue; } r -= IT_BRC;
        if (r < IT_OUT) { const int kb = r / 32, nb = r % 32; transpose_item(p.in[23] + (size_t)l * 1024 * 1024, 1024, (f16*)(wl + WO_OUT), 1024, 32 * nb, 0, scr, 64 * kb, 32 * nb, F.lane); continue; } r -= IT_OUT;
        if (r < IT_UP) { const int kb = r / 176, nb = r % 176; const int n0 = 32 * nb; const int j = n0 < DFF ? n0 : n0 - DFF; const int drow = (j / 128) * 256 + (n0 < DFF ? 0 : 128) + (j % 128);
            transpose_item(p.in[25] + (size_t)l * 1024 * 5632, 5632, (f16*)(wl + WO_UP), 1024, drow, 0, scr, 64 * kb, n0, F.lane); continue; } r -= IT_UP;
        { const int kb = r / 32, nb = r % 32; transpose_item(p.in[28] + (size_t)l * 2816 * 1024, 1024, (f16*)(wl + WO_DOWN), 2816, 32 * nb, 0, scr, 64 * kb, 32 * nb, F.lane); }
    }
    const int gt = F.vcu * NTHREADS + F.tid, NGT = F.G * NTHREADS;
    for (int l = 0; l < 2; ++l) {
        unsigned char* wl = F.ws + WS_W + (size_t)l * WL_BYTES;
        u32x4* z1 = (u32x4*)(wl + WO_IN + (size_t)1696 * 1024 * 2);
        for (int i = gt; i < 96 * 1024 * 2 / 16; i += NGT) z1[i] = (u32x4){0u, 0u, 0u, 0u};
        for (int i = gt; i < 512 * 512 / 8; i += NGT) { const int n = i / 64, k8 = i % 64; if ((n >> 7) != (k8 >> 4)) *(u32x4*)(wl + WO_POOL + ((size_t)n * 512 + k8 * 8) * 2) = (u32x4){0u, 0u, 0u, 0u}; }
    }
}

__device__ __forceinline__ void p0_mod(const Frame& F_, const Params& p) {
    Frame F = F_; { int t_ = threadIdx.x; asm volatile("" : "+v"(t_)); F.tid = t_; F.lane = t_ & 63; F.wave = __builtin_amdgcn_readfirstlane(t_ >> 6); }
    LAS float* red = (LAS float*)(F.lds);
    float* modf = (float*)(F.ws + WS_CTL + CTL_MOD);
    for (int it = F.vcu; it < 2 * 96; it += F.G) {
        const int l = it / 96, c0 = (it % 96) * 64;
        const float* W = p.in[8] + (size_t)l * 1024 * NMOD + c0 + F.lane;
        float a0 = 0.f, a1 = 0.f, a2 = 0.f;
        const int kb = F.wave * 128;
#pragma unroll 8
        for (int k = 0; k < 128; ++k) {
            const float w = W[(size_t)(kb + k) * NMOD];
            const float x0 = p.in[7][kb + k], x1 = p.in[2][kb + k], x2 = p.in[2][1024 + kb + k];
            a0 += siluf_(x0) * w; a1 += siluf_(x1) * w; a2 += siluf_(x2) * w;
        }
        __syncthreads();
        red[(F.wave * 3 + 0) * 64 + F.lane] = a0; red[(F.wave * 3 + 1) * 64 + F.lane] = a1; red[(F.wave * 3 + 2) * 64 + F.lane] = a2;
        __syncthreads();
        if (F.tid < 192) {
            const int j = F.tid / 64, c = F.tid % 64; float s = 0.f;
#pragma unroll
            for (int w = 0; w < 8; ++w) s += red[(w * 3 + j) * 64 + c];
            modf[((size_t)l * 3 + j) * NMOD + c0 + c] = s + p.in[9][(size_t)l * NMOD + c0 + c];
        }
    }
    __syncthreads();
}

__device__ __forceinline__ void p0_tables(const Frame& F_) {
    Frame F = F_; F.tid = threadIdx.x;
    if (F.vcu != F.G - 1) return;
    float* tm = (float*)(F.ws + WS_CTL + CTL_TABM); float* tg = (float*)(F.ws + WS_CTL + CTL_TABG);
    for (int e = F.tid; e < 64 * 8 + 64 * 16; e += NTHREADS) {
        const bool isg = e >= 512; const int ee = isg ? e - 512 : e; const int nf = isg ? 16 : 8; const int pos = ee / nf, i = ee % nf;
        const float fr32 = exp2f(-13.287712379549449f * (float)(2 * i) / (float)(2 * nf));
        const float ang = (float)pos * fr32;
        double x = (double)ang; const double twopi = 6.283185307179586476925286766559;
        const double kq = __builtin_floor(x / twopi + 0.5); x -= kq * twopi;
        double x2 = x * x, cs = 1.0, sn = x, tc = 1.0, ts = x;
#pragma unroll 1
        for (int n = 1; n <= 14; ++n) { tc *= -x2 / (double)((2 * n - 1) * (2 * n)); ts *= -x2 / (double)((2 * n) * (2 * n + 1)); cs += tc; sn += ts; }
        float* dst = isg ? tg + (size_t)ee * 2 : tm + (size_t)ee * 2;
        dst[0] = (float)cs; dst[1] = (float)sn;
    }
}

__device__ __forceinline__ void norm_mod_phase(const Frame& F_, const float* srcP, const float* srcS, const float* g, const float* modsh, const float* modsc, f16* H) {
    Frame F = F_; { int t_ = threadIdx.x; asm volatile("" : "+v"(t_)); F.tid = t_; F.lane = t_ & 63; F.wave = __builtin_amdgcn_readfirstlane(t_ >> 6); }
    const int gw = F.vcu * NWAVES + F.wave, NGW = F.G * NWAVES;
    for (int row = gw; row < NTOK; row += NGW) {
        const float* xr = row < NCTX ? srcP + (size_t)row * DM : srcS + (size_t)(row - NCTX) * DM;
        const int cls = mod_class(row);
        f32x4 v[4]; float s = 0.f;
#pragma unroll
        for (int j = 0; j < 4; ++j) { v[j] = *(const f32x4*)(xr + 4 * F.lane + 256 * j); s += (v[j].x * v[j].x + v[j].y * v[j].y) + (v[j].z * v[j].z + v[j].w * v[j].w); }
        const float rstd = 1.0f / sqrtf(wave_sum(s) * (1.0f / DM) + RMS_EPS);
#pragma unroll
        for (int j = 0; j < 4; ++j) {
            const int c = 4 * F.lane + 256 * j;
            const f32x4 gg = *(const f32x4*)(g + c), sc = *(const f32x4*)(modsc + cls * NMOD + c), sh = *(const f32x4*)(modsh + cls * NMOD + c);
            const f32x4 o = v[j] * rstd * gg * (sc + 1.0f) + sh;
            u32x2 w; w.x = pk2h(o.x, o.y); w.y = pk2h(o.z, o.w);
            *(u32x2*)(H + (size_t)row * DM + c) = w;
        }
    }
}
__device__ __forceinline__ void final_norm_phase(const Frame& F_, float* X, const float* g) {
    Frame F = F_; { int t_ = threadIdx.x; asm volatile("" : "+v"(t_)); F.tid = t_; F.lane = t_ & 63; F.wave = __builtin_amdgcn_readfirstlane(t_ >> 6); }
    const int gw = F.vcu * NWAVES + F.wave, NGW = F.G * NWAVES;
    for (int row = gw; row < NTOK; row += NGW) {
        float* xr = X + (size_t)row * DM;
        f32x4 v[4]; float s = 0.f;
#pragma unroll
        for (int j = 0; j < 4; ++j) { v[j] = *(const f32x4*)(xr + 4 * F.lane + 256 * j); s += (v[j].x * v[j].x + v[j].y * v[j].y) + (v[j].z * v[j].z + v[j].w * v[j].w); }
        const float rstd = 1.0f / sqrtf(wave_sum(s) * (1.0f / DM) + RMS_EPS);
#pragma unroll
        for (int j = 0; j < 4; ++j) { const int c = 4 * F.lane + 256 * j; *(f32x4*)(xr + c) = v[j] * rstd * *(const f32x4*)(g + c); }
    }
}

__device__ __forceinline__ void token_phase(const Frame& F_, const Params& p, int l) {
    Frame F = F_; { int t_ = threadIdx.x; asm volatile("" : "+v"(t_)); F.tid = t_; F.lane = t_ & 63; F.wave = __builtin_amdgcn_readfirstlane(t_ >> 6); }
    const f16* Z = (const f16*)(F.ws + WS_ZS);
    f16* QA = (f16*)(F.ws + WS_QA); f16* PL = (f16*)(F.ws + WS_PL); f16* CKV = (f16*)(F.ws + WS_CKV);
    f16* QG = (f16*)(F.ws + WS_QG); f16* KG = (f16*)(F.ws + WS_KG); f16* VG = (f16*)(F.ws + WS_VG); f16* KR = (f16*)(F.ws + WS_KR);
    const float* tabM = (const float*)(F.ws + WS_CTL + CTL_TABM); const float* tabG = (const float*)(F.ws + WS_CTL + CTL_TABG);
    const float* g_q_a = p.in[12] + l * 256; const float* g_kv_a = p.in[14] + l * 128; const float* g_q_gqa = p.in[16] + l * 64; const float* g_k_gqa = p.in[17] + l * 64;
    const int lane = F.lane;
    const int gw = F.vcu * NWAVES + F.wave, NGW = F.G * NWAVES;
    for (int row = gw; row < NTOK + 2 * PAST; row += NGW) {
        if (row >= NTOK) {
            const int cr = row - NTOK, b = cr / PAST, j = cr % PAST;
            const size_t kvrow = (size_t)NCTX + (size_t)KVL * b + SEQL + j;
            const size_t crow_ = ((size_t)b * 2 + l) * PAST + j;
            { const f32x2 v = *(const f32x2*)(p.in[3] + crow_ * 128 + 2 * lane); *(unsigned*)(CKV + kvrow * 128 + 2 * lane) = pk2h(v.x, v.y); }
            if (lane < 16) { const f32x2 v = *(const f32x2*)(p.in[4] + crow_ * 32 + 2 * lane); *(unsigned*)(KR + kvrow * 32 + 2 * lane) = pk2h(v.x, v.y); }
            { const f32x2 v = *(const f32x2*)(p.in[5] + crow_ * 128 + 2 * lane); *(unsigned*)(KG + kvrow * 128 + 2 * lane) = pk2h(v.x, v.y); }
            { const f32x2 v = *(const f32x2*)(p.in[6] + crow_ * 128 + 2 * lane); *(unsigned*)(VG + kvrow * 128 + 2 * lane) = pk2h(v.x, v.y); }
            continue;
        }
        const bool lat = row >= NCTX;
        const int tl = lat ? ((row - NCTX) & (SEQL - 1)) : (row & (SEQC - 1));
        const int T = lat ? SEQL : SEQC;
        const size_t kvrow = lat ? (size_t)NCTX + (size_t)KVL * ((row - NCTX) >> 12) + tl : (size_t)row;
        const int prow = tl >> 6, pcol = tl & 63;
        const f16* z = Z + (size_t)row * ZS;
        const size_t ob = lat ? 0 : ((size_t)(row >> 8) * 2 + l) * SEQC + tl;
        { const u32x2 w = *(const u32x2*)(z + ZC_QA + 4 * lane);
          float v0 = h_lo(w.x), v1 = h_hi(w.x), v2 = h_lo(w.y), v3 = h_hi(w.y);
          const float rstd = 1.0f / sqrtf(wave_sum(v0 * v0 + v1 * v1 + v2 * v2 + v3 * v3) * (1.0f / 256.0f) + RMS_EPS);
          const f32x4 g = *(const f32x4*)(g_q_a + 4 * lane);
          u32x2 o; o.x = pk2h(v0 * rstd * g.x, v1 * rstd * g.y); o.y = pk2h(v2 * rstd * g.z, v3 * rstd * g.w);
          *(u32x2*)(QA + (size_t)row * 256 + 4 * lane) = o; }
        { const unsigned w = *(const unsigned*)(z + ZC_CKV + 2 * lane);
          float v0 = h_lo(w), v1 = h_hi(w);
          const float rstd = 1.0f / sqrtf(wave_sum(v0 * v0 + v1 * v1) * (1.0f / 128.0f) + RMS_EPS);
          const f32x2 g = *(const f32x2*)(g_kv_a + 2 * lane);
          v0 = v0 * rstd * g.x; v1 = v1 * rstd * g.y;
          *(unsigned*)(CKV + kvrow * 128 + 2 * lane) = pk2h(v0, v1);
          if (!lat) *(f32x2*)(p.out + OUT_CKV + ob * 128 + 2 * lane) = (f32x2){v0, v1}; }
        { float v = (lane < 32) ? (float)z[ZC_KR + lane] : 0.f;
          if (!lat) { if (lane < 32) p.out[OUT_KR + ob * 32 + lane] = v; }
          else { const float other = __shfl_xor(v, 8); const int d = lane & 31, i = d & 15; const int pos = (d < 16) ? prow : pcol;
                 const float c = tabM[(pos * 8 + (i & 7)) * 2], s = tabM[(pos * 8 + (i & 7)) * 2 + 1];
                 v = (i < 8) ? (v * c - other * s) : (other * s + v * c); }
          if (lane < 32) KR[kvrow * 32 + lane] = (f16)v; }
        { const u32x4 w = *(const u32x4*)(z + ZC_GQ + 8 * lane);
          float v[8] = {h_lo(w.x), h_hi(w.x), h_lo(w.y), h_hi(w.y), h_lo(w.z), h_hi(w.z), h_lo(w.w), h_hi(w.w)};
          float s = 0.f;
#pragma unroll
          for (int e = 0; e < 8; ++e) s += v[e] * v[e];
          s += __shfl_xor(s, 1); s += __shfl_xor(s, 2); s += __shfl_xor(s, 4);
          const float rstd = 1.0f / sqrtf(s * (1.0f / 64.0f) + RMS_EPS);
          const int d0 = 8 * (lane & 7);
#pragma unroll
          for (int e = 0; e < 8; ++e) v[e] = v[e] * rstd * g_q_gqa[d0 + e];
          if (lat) { const int i0 = d0 & 31; const int pos = (d0 < 32) ? prow : pcol; const bool first = i0 < 16;
#pragma unroll
              for (int e = 0; e < 8; ++e) { const float other = __shfl_xor(v[e], 2); const int fi = (i0 & 15) + e;
                  const float c = tabG[(pos * 16 + fi) * 2], sn = tabG[(pos * 16 + fi) * 2 + 1];
                  v[e] = first ? (v[e] * c - other * sn) : (other * sn + v[e] * c); } }
#pragma unroll
          for (int e = 0; e < 8; ++e) v[e] *= SCALE_GQA;
          u32x4 o; o.x = pk2h(v[0], v[1]); o.y = pk2h(v[2], v[3]); o.z = pk2h(v[4], v[5]); o.w = pk2h(v[6], v[7]);
          *(u32x4*)(QG + (size_t)row * 512 + 8 * lane) = o; }
        { const unsigned w = *(const unsigned*)(z + ZC_GK + 2 * lane);
          float v0 = h_lo(w), v1 = h_hi(w);
          float s = v0 * v0 + v1 * v1;
#pragma unroll
          for (int o = 1; o < 32; o <<= 1) s += __shfl_xor(s, o);
          const float rstd = 1.0f / sqrtf(s * (1.0f / 64.0f) + RMS_EPS);
          const int d0 = 2 * (lane & 31);
          v0 = v0 * rstd * g_k_gqa[d0]; v1 = v1 * rstd * g_k_gqa[d0 + 1];
          if (!lat) *(f32x2*)(p.out + OUT_GK + ob * 128 + 2 * lane) = (f32x2){v0, v1};
          else { const int i0 = d0 & 31; const int pos = (d0 < 32) ? prow : pcol; const bool first = i0 < 16;
                 const float o0 = __shfl_xor(v0, 8), o1 = __shfl_xor(v1, 8); const int fi = i0 & 15;
                 const float c0 = tabG[(pos * 16 + fi) * 2], s0 = tabG[(pos * 16 + fi) * 2 + 1], c1 = tabG[(pos * 16 + fi + 1) * 2], s1 = tabG[(pos * 16 + fi + 1) * 2 + 1];
                 v0 = first ? (v0 * c0 - o0 * s0) : (o0 * s0 + v0 * c0); v1 = first ? (v1 * c1 - o1 * s1) : (o1 * s1 + v1 * c1); }
          *(unsigned*)(KG + kvrow * 128 + 2 * lane) = pk2h(v0, v1); }
        { const unsigned w = *(const unsigned*)(z + ZC_GV + 2 * lane);
          *(unsigned*)(VG + kvrow * 128 + 2 * lane) = w;
          if (!lat) *(f32x2*)(p.out + OUT_GV + ob * 128 + 2 * lane) = (f32x2){h_lo(w), h_hi(w)}; }
        { const int g = lane >> 4, wsz = 2 << g, c8 = (lane & 15) * 8;
          const int lo = max(tl - wsz / 2, 0), hi = min(tl - wsz / 2 + wsz, T);
          const f16* zc = z + ZC_PL + g * 128 + c8;
          float acc[8] = {0.f, 0.f, 0.f, 0.f, 0.f, 0.f, 0.f, 0.f};
          for (int k = 0; k < 16; ++k) {
              const int tt = lo + k;
              if (tt < hi) { const u32x4 w = *(const u32x4*)(zc + (ptrdiff_t)(tt - tl) * ZS);
                  acc[0] += h_lo(w.x); acc[1] += h_hi(w.x); acc[2] += h_lo(w.y); acc[3] += h_hi(w.y); acc[4] += h_lo(w.z); acc[5] += h_hi(w.z); acc[6] += h_lo(w.w); acc[7] += h_hi(w.w); }
          }
          const float inv = 1.0f / (float)(hi - lo);
          const u32x4 w = *(const u32x4*)zc;
          const float own[8] = {h_lo(w.x), h_hi(w.x), h_lo(w.y), h_hi(w.y), h_lo(w.z), h_hi(w.z), h_lo(w.w), h_hi(w.w)};
          u32x4 o; o.x = pk2h(acc[0] * inv - own[0], acc[1] * inv - own[1]); o.y = pk2h(acc[2] * inv - own[2], acc[3] * inv - own[3]);
          o.z = pk2h(acc[4] * inv - own[4], acc[5] * inv - own[5]); o.w = pk2h(acc[6] * inv - own[6], acc[7] * inv - own[7]);
          *(u32x4*)(PL + (size_t)row * 512 + g * 128 + c8) = o; }
    }
}

__device__ __forceinline__ void fixup_phase(const Frame& F_, const Params& p, int l) {
    Frame F = F_; { int t_ = threadIdx.x; asm volatile("" : "+v"(t_)); F.tid = t_; F.lane = t_ & 63; F.wave = __builtin_amdgcn_readfirstlane(t_ >> 6); }
    const float* E = (const float*)(F.ws + WS_EDGE); const float* VE = (const float*)(F.ws + WS_VEDGE); f16* act = (f16*)(F.ws + WS_ACT);
    const float* cw = p.in[26] + (size_t)l * 3 * DFF; const float* cb = p.in[27] + (size_t)l * DFF;
    const int gw = F.vcu * NWAVES + F.wave, NGW = F.G * NWAVES;
    for (int it = gw; it < 512; it += NGW) {
        const int chunk = it >> 1, side = it & 1;
        const int row = chunk * 64 + (side ? 63 : 0);
        const bool lat = row >= NCTX; const int tl = lat ? ((row - NCTX) & (SEQL - 1)) : (row & (SEQC - 1)); const int T = lat ? SEQL : SEQC;
        const float* prev; const float* cur; const float* nxt; bool hasp = true, hasn = true;
        if (side == 0) { hasp = tl > 0; prev = E + ((size_t)(chunk - 1) * 4 + 3) * DFF; cur = E + ((size_t)chunk * 4 + 0) * DFF; nxt = E + ((size_t)chunk * 4 + 1) * DFF; }
        else { hasn = tl < T - 1; prev = E + ((size_t)chunk * 4 + 2) * DFF; cur = E + ((size_t)chunk * 4 + 3) * DFF; nxt = E + ((size_t)(chunk + 1) * 4 + 0) * DFF; }
        const float* val = VE + ((size_t)chunk * 2 + side) * DFF;
        for (int c = 4 * F.lane; c < DFF; c += 256) {
            const f32x4 zero = {0.f, 0.f, 0.f, 0.f};
            const f32x4 pv = hasp ? *(const f32x4*)(prev + c) : zero, cv = *(const f32x4*)(cur + c), nv = hasn ? *(const f32x4*)(nxt + c) : zero, vv = *(const f32x4*)(val + c);
            const f32x4 g = *(const f32x4*)(cw + c) * pv + *(const f32x4*)(cw + DFF + c) * cv + *(const f32x4*)(cw + 2 * DFF + c) * nv + *(const f32x4*)(cb + c);
            u32x2 w; w.x = pk2h(siluf_(g.x) * vv.x, siluf_(g.y) * vv.y); w.y = pk2h(siluf_(g.z) * vv.z, siluf_(g.w) * vv.w);
            *(u32x2*)(act + (size_t)row * DFF + c) = w;
        }
    }
}

__device__ __forceinline__ void attn_one(const Frame& F, int kind  , int u) {
    const f16* QM = (const f16*)(F.ws + WS_QM); const f16* QG = (const f16*)(F.ws + WS_QG); const f16* KV = (const f16*)(F.ws + WS_KV);
    const f16* KR = (const f16*)(F.ws + WS_KR); const f16* KG = (const f16*)(F.ws + WS_KG); const f16* VG = (const f16*)(F.ws + WS_VG); f16* ABO = (f16*)(F.ws + WS_ABO);
    int tok0, kv0, ntiles, hh;
    if (kind == 0) { const int b = u >> 8, qb = u & 15; hh = (u >> 4) & 15; tok0 = NCTX + b * SEQL + qb * 256; kv0 = NCTX + b * KVL; ntiles = KVL / 64; }
    else { const int s = u >> 4; hh = u & 15; tok0 = s * SEQC; kv0 = s * SEQC; ntiles = SEQC / 64; }
    if (hh < 8) {
        attn::Src s{KV + (size_t)kv0 * 1024 + hh * 128, 1024, KR + (size_t)kv0 * 32, 32, KV + (size_t)kv0 * 1024 + hh * 128 + 64, 1024};
        attn::unit<96>(F.lds, QM + (size_t)tok0 * 768 + hh * 96, 768, s, ntiles, ABO + (size_t)tok0 * 1024 + hh * 64, 1024);
    } else {
        const int h = hh - 8, g = h >> 2;
        attn::Src s{KG + (size_t)kv0 * 128 + g * 64, 128, nullptr, 0, VG + (size_t)kv0 * 128 + g * 64, 128};
        attn::unit<64>(F.lds, QG + (size_t)tok0 * 512 + h * 64, 512, s, ntiles, ABO + (size_t)tok0 * 1024 + 512 + h * 64, 1024);
    }
}
__device__ __forceinline__ void attn_phase(const Frame& F) {
    for (int u = F.vcu; u < 256; u += F.G) { attn_one(F, 0, u); attn_one(F, 0, 511 - u); }
    for (int u = F.vcu; u < 256; u += F.G) { attn_one(F, 1, u); attn_one(F, 1, 511 - u); }
}

__global__ void __launch_bounds__(NTHREADS, 2) fwd_kernel(Params p) {
    extern __shared__ __attribute__((aligned(16))) unsigned char lds_raw[];
    Frame F;
    F.lds = (LAS unsigned char*)lds_raw;
    F.tid = 0; F.lane = 0; F.wave = 0;
    F.G = gridDim.x; { const int bx = blockIdx.x; F.vcu = (F.G % 8 == 0) ? (bx % 8) * (F.G / 8) + bx / 8 : bx; }
    F.ws = p.ws; F.out = p.out;
#if USE_CG
    cg::grid_group grid = cg::this_grid();
#define GRID_BAR() grid.sync()
#else
    { cg::grid_group grid = cg::this_grid(); if (p.ws == nullptr) grid.sync(); }
    for (int u = threadIdx.x; u < (LDS_BYTES - LDSCTL_OFF) / 4; u += NTHREADS) ((LAS unsigned*)(F.lds + LDSCTL_OFF))[u] = 0u;
    __syncthreads();
    XcdBarrier bar = xcd_barrier_post((unsigned*)(F.ws + WS_CTL) + 1024, (volatile LAS unsigned*)(F.lds + LDSCTL_OFF + 64));
#define GRID_BAR() xcd_barrier(bar)
#endif
    unsigned char* ws = F.ws;
    const float* modf = (const float*)(ws + WS_CTL + CTL_MOD);

    RUNPH(0, p0_convert(F, p); __syncthreads(); p0_mod(F, p); p0_tables(F));
    GRID_BAR();

#pragma unroll 1
    for (int step = 0; step < 26; ++step) {
        const int l = step / 13, k = step % 13;
        unsigned char* wl = ws + WS_W + (size_t)l * WL_BYTES;
        const float* modl = modf + (size_t)l * 3 * NMOD;
        const float* xP = (l == 0) ? p.in[0] : p.out;
        const float* xS = (l == 0) ? p.in[1] : p.out + (size_t)NCTX * DM;
        bool do_bar = true;
        if (k == 0 || k == 9) {
            const float* nP = (k == 0) ? xP : p.out; const float* nS = (k == 0) ? xS : p.out + (size_t)NCTX * DM;
            const float* ng = (k == 0) ? p.in[10] + l * DM : p.in[24] + l * DM; const float* nm = (k == 0) ? modl : modl + 3072;
            RUNPH(1, norm_mod_phase(F, nP, nS, ng, nm, nm + 1024, (f16*)(ws + WS_H)));
        } else if (k == 1 || k == 3 || k == 4 || k == 5) {
            pg8::SchedPlain S; pg8::EpiF16 E;
            if (k == 1)      { S.T.init(64, 7, F.G, (int)blockIdx.x); S.A = (const char*)(ws + WS_H);   S.B = (const char*)(wl + WO_IN);   S.lda = 1024; S.ldb = 1024; S.nt = 16; S.koff = 0;
                               E = pg8::EpiF16{(f16*)(ws + WS_ZS), ZS, 0, nullptr, 1.f}; }
            else if (k == 3) { S.T.init(64, 3, F.G, (int)blockIdx.x); S.A = (const char*)(ws + WS_QA);  S.B = (const char*)(wl + WO_QB);   S.lda = 256;  S.ldb = 256;  S.nt = 4;  S.koff = 0;
                               E = pg8::EpiF16{(f16*)(ws + WS_QM), 768, 1, (const float*)(ws + WS_CTL + CTL_TABM), SCALE_MLA}; do_bar = false; }
            else if (k == 4) { S.T.init(68, 4, F.G, (int)blockIdx.x); S.A = (const char*)(ws + WS_CKV); S.B = (const char*)(wl + WO_KVB);  S.lda = 128;  S.ldb = 128;  S.nt = 2;  S.koff = 0;
                               E = pg8::EpiF16{(f16*)(ws + WS_KV), 1024, 0, nullptr, 1.f}; do_bar = false; }
            else             { S.T.init(64, 2, F.G, (int)blockIdx.x); S.A = (const char*)(ws + WS_PL);  S.B = (const char*)(wl + WO_POOL); S.lda = 512;  S.ldb = 512;  S.nt = 4;  S.koff = 256;
                               E = pg8::EpiF16{(f16*)(ws + WS_CO), 1024, 2, p.in[19] + l * 512, 1.f}; }
            RUNPH(2, pg8::gemm_phase<pg8::EpiF16, pg8::SchedPlain, true>(F.lds, S.lda, S.ldb, S, E));
        } else if (k == 2) {
            RUNPH(3, token_phase(F, p, l));
        } else if (k == 6) {
            RUNPH(7, attn_phase(F));
        } else if (k == 7) {
            pg8::SchedMerge S; S.T.init(64, 4, F.G, (int)blockIdx.x); S.Hh = (const char*)(ws + WS_H); S.ABO = (const char*)(ws + WS_ABO); S.CO = (const char*)(ws + WS_CO);
            S.Wg = (const char*)(wl + WO_G); S.Wab = (const char*)(wl + WO_BRAB); S.Wc = (const char*)(wl + WO_BRC);
            pg8::EpiMerge E{ws + WS_GSCR + (size_t)blockIdx.x * 131072, (f16*)(ws + WS_MERGED)};
            RUNPH(8, pg8::gemm_phase<pg8::EpiMerge, pg8::SchedMerge, false>(F.lds, 1024, 1024, S, E));
        } else if (k == 8 || k == 12) {
            pg8::SchedPlain S; pg8::EpiRes E;
            S.T.init(64, 4, F.G, (int)blockIdx.x); S.koff = 0;
            if (k == 8) { S.A = (const char*)(ws + WS_MERGED); S.B = (const char*)(wl + WO_OUT);  S.lda = 1024; S.ldb = 1024; S.nt = 16; E = pg8::EpiRes{xP, xS, p.out, modl + 2048}; }
            else        { S.A = (const char*)(ws + WS_ACT);    S.B = (const char*)(wl + WO_DOWN); S.lda = DFF;  S.ldb = DFF;  S.nt = 44; E = pg8::EpiRes{p.out, p.out + (size_t)NCTX * DM, p.out, modl + 5120}; }
            pg8::gemm_phase<pg8::EpiRes, pg8::SchedPlain, false>(F.lds, S.lda, S.ldb, S, E);
        } else if (k == 10) {
            pg8::SchedPlain S; S.T.init(64, 22, F.G, (int)blockIdx.x); S.A = (const char*)(ws + WS_H); S.B = (const char*)(wl + WO_UP); S.lda = 1024; S.ldb = 1024; S.nt = 16; S.koff = 0;
            pg8::EpiUp E{(f16*)(ws + WS_ACT), (float*)(ws + WS_EDGE), (float*)(ws + WS_VEDGE), p.in[26] + (size_t)l * 3 * DFF, p.in[27] + (size_t)l * DFF};
            RUNPH(11, pg8::gemm_phase<pg8::EpiUp, pg8::SchedPlain, true>(F.lds, 1024, 1024, S, E));
        } else {
            RUNPH(12, fixup_phase(F, p, l));
        }
        if (do_bar) GRID_BAR();
    }
    final_norm_phase(F, p.out, p.in[29]);
}

extern "C" void kernel_launch(void* const* d_in, const int* in_sizes, int n_in, void* d_out, int out_size, void* d_ws, size_t ws_size, hipStream_t stream) {
    static int grid = 0;
    if (grid == 0) {
        if (n_in != 30 || ws_size < WS_END) { fprintf(stderr, "kernel_launch: unexpected arguments (n_in %d, ws %zu)\n", n_in, ws_size); grid = -1; return; }
        int dev = 0, cus = 0, per_cu = 0;
        hipGetDevice(&dev);
        hipDeviceGetAttribute(&cus, hipDeviceAttributeMultiprocessorCount, dev);
        hipFuncSetAttribute((const void*)fwd_kernel, hipFuncAttributeMaxDynamicSharedMemorySize, LDS_BYTES);
        hipOccupancyMaxActiveBlocksPerMultiprocessor(&per_cu, (const void*)fwd_kernel, NTHREADS, LDS_BYTES);
        if (per_cu < 1) { fprintf(stderr, "kernel_launch: occupancy query says %d blocks per CU\n", per_cu); per_cu = 1; }
        (void)hipGetLastError();
        grid = cus;
    }
    if (grid < 0) return;
    hipMemsetAsync((char*)d_ws + WS_CTL, 0, CTL_ZERO_BYTES, stream);
    Params p{};
    for (int i = 0; i < 30; ++i) p.in[i] = (const float*)d_in[i];
    p.out = (float*)d_out; p.ws = (unsigned char*)d_ws;
    void* args[] = {&p};
    hipError_t e = hipLaunchCooperativeKernel((const void*)fwd_kernel, dim3(grid), dim3(NTHREADS), args, LDS_BYTES, stream);
    if (e != hipSuccess) fprintf(stderr, "kernel_launch: cooperative launch failed: %s (grid %d)\n", hipGetErrorString(e), grid);
}
```

```cpp
#include <hip/hip_runtime.h>
#include <hip/hip_cooperative_groups.h>
#include <cstdio>
#include <cstdint>
namespace cg = cooperative_groups;

#ifndef PHASE_MASK
#define PHASE_MASK 0xFFFFFFFFu
#endif
#define PH(k) (((PHASE_MASK) >> (k)) & 1u)
#ifndef REPEAT_MASK
#define REPEAT_MASK 0u
#endif
#define NREP(k) (1 + (((REPEAT_MASK) >> (k)) & 1u))
#define RUNPH(k, ...) do { for (int rep_ = 0; rep_ < (int)NREP(k); ++rep_) { if (rep_) GRID_BAR(); __VA_ARGS__; } } while (0)
#ifndef USE_CG
#define USE_CG 0
#endif

#define LAS __attribute__((address_space(3)))
#define GAS __attribute__((address_space(1)))
typedef _Float16 f16;
typedef _Float16 h8 __attribute__((ext_vector_type(8)));
typedef _Float16 h4 __attribute__((ext_vector_type(4)));
typedef _Float16 h2 __attribute__((ext_vector_type(2)));
typedef float f32x2 __attribute__((ext_vector_type(2)));
typedef float f32x4 __attribute__((ext_vector_type(4)));
typedef float f32x16 __attribute__((ext_vector_type(16)));
typedef unsigned u32x2 __attribute__((ext_vector_type(2)));
typedef unsigned u32x4 __attribute__((ext_vector_type(4)));
typedef short s16x4 __attribute__((ext_vector_type(4)));

constexpr int DM = 1024, NTOK = 16384, NCTX = 8192, SEQC = 256, SEQL = 4096, PAST = 512, NKV = 17408, KVL = 4608;
constexpr int ZS = 1792, DFF = 2816, NMOD = 6144;
constexpr float RMS_EPS = 1e-6f;
constexpr float LOG2E = 1.4426950408889634f;
constexpr float SCALE_MLA = 0.10206207261596575f * LOG2E;
constexpr float SCALE_GQA = 0.125f * LOG2E;
constexpr int ZC_QA = 0, ZC_CKV = 256, ZC_KR = 384, ZC_GQ = 416, ZC_GK = 928, ZC_GV = 1056, ZC_PL = 1184, ZC_END = 1696;

constexpr size_t MiB = 1u << 20;
constexpr size_t WS_CTL = 0;
constexpr size_t CTL_ZERO_BYTES = 65536;
constexpr size_t CTL_MOD = 65536;
constexpr size_t CTL_TABM = CTL_MOD + 2 * 3 * 6144 * 4;
constexpr size_t CTL_TABG = CTL_TABM + 64 * 8 * 2 * 4;
constexpr size_t WS_W = 1 * MiB;
constexpr size_t WO_IN = 0;
constexpr size_t WO_G = WO_IN + (size_t)1792 * 1024 * 2;
constexpr size_t WO_QB = WO_G + (size_t)3072 * 1024 * 2;
constexpr size_t WO_KVB = WO_QB + (size_t)768 * 256 * 2;
constexpr size_t WO_POOL = WO_KVB + (size_t)1024 * 128 * 2;
constexpr size_t WO_BRAB = WO_POOL + (size_t)512 * 512 * 2;
constexpr size_t WO_BRC = WO_BRAB + (size_t)1024 * 1024 * 2;
constexpr size_t WO_OUT = WO_BRC + (size_t)1024 * 1024 * 2;
constexpr size_t WO_UP = WO_OUT + (size_t)1024 * 1024 * 2;
constexpr size_t WO_DOWN = WO_UP + (size_t)5632 * 1024 * 2;
constexpr size_t WL_BYTES = WO_DOWN + (size_t)1024 * 2816 * 2;
static_assert(WL_BYTES == 33 * MiB + MiB / 8, "weight map");
constexpr size_t WS_H = WS_W + 2 * WL_BYTES;
constexpr size_t WS_B = WS_H + 32 * MiB;
constexpr size_t WS_C = WS_B + 66 * MiB;
constexpr size_t WS_D = WS_C + 58 * MiB;
constexpr size_t WS_END = WS_D + 32 * MiB;
static_assert(WS_END <= 256 * MiB, "workspace");
constexpr size_t WS_ZS = WS_B;
constexpr size_t WS_KV = WS_B;
constexpr size_t WS_CO = WS_B + 34 * MiB;
constexpr size_t WS_GSCR = WS_B;
constexpr size_t WS_QA = WS_C;
constexpr size_t WS_PL = WS_C + 8 * MiB;
constexpr size_t WS_CKV = WS_C + 24 * MiB;
constexpr size_t WS_ABO = WS_C;
constexpr size_t WS_QG = WS_C + 32 * MiB;
constexpr size_t WS_KG = WS_C + 48 * MiB;
constexpr size_t WS_VG = WS_KG + (size_t)NKV * 128 * 2;
constexpr size_t WS_KR = WS_VG + (size_t)NKV * 128 * 2;
static_assert(WS_KR + (size_t)NKV * 32 * 2 <= WS_D, "region C");
constexpr size_t WS_QM = WS_D;
constexpr size_t WS_MERGED = WS_D;
constexpr size_t WS_ACT = WS_B;
constexpr size_t WS_EDGE = WS_B + 88 * MiB;
constexpr size_t WS_VEDGE = WS_EDGE + (size_t)256 * 4 * 2816 * 4;
static_assert(WS_VEDGE + (size_t)256 * 2 * 2816 * 4 <= WS_D, "ffn side buffers");

constexpr size_t OUT_Y = 0;
constexpr size_t OUT_CKV = (size_t)NTOK * DM;
constexpr size_t OUT_KR = OUT_CKV + (size_t)32 * 2 * 256 * 128;
constexpr size_t OUT_GK = OUT_KR + (size_t)32 * 2 * 256 * 32;
constexpr size_t OUT_GV = OUT_GK + (size_t)32 * 2 * 256 * 128;

constexpr int RING_BYTES = 131072;
constexpr int LDSCTL_OFF = RING_BYTES;
constexpr int LDS_BYTES = 147456;
constexpr int NWAVES = 8, NTHREADS = 512;

struct Params { const float* in[30]; float* out; unsigned char* ws; };

__device__ __forceinline__ float wave_sum(float v) {
#pragma unroll
    for (int o = 1; o < 64; o <<= 1) v += __shfl_xor(v, o);
    return v;
}
__device__ __forceinline__ unsigned pk2h(float lo, float hi) { h2 v; v.x = (f16)lo; v.y = (f16)hi; return __builtin_bit_cast(unsigned, v); }
__device__ __forceinline__ float h_lo(unsigned u) { h2 v = __builtin_bit_cast(h2, u); return (float)v.x; }
__device__ __forceinline__ float h_hi(unsigned u) { h2 v = __builtin_bit_cast(h2, u); return (float)v.y; }
__device__ __forceinline__ float fast_exp2(float x) { return __builtin_amdgcn_exp2f(x); }
__device__ __forceinline__ float sigmoidf_(float x) { return __builtin_amdgcn_rcpf(1.0f + __builtin_amdgcn_exp2f(x * -LOG2E)); }
__device__ __forceinline__ float siluf_(float x) { return x * __builtin_amdgcn_rcpf(1.0f + __builtin_amdgcn_exp2f(x * -LOG2E)); }
__device__ __forceinline__ int mod_class(int row) { return row < NCTX ? 0 : (row < NCTX + SEQL ? 1 : 2); }

namespace pg8 {
constexpr int BM = 256, BK = 64, HALF = 128, HTB = HALF * BK * 2, STAGE_BYTES = 8 * HTB, NXCD = 8, WGM = 8;
__host__ __device__ __forceinline__ int lds_byte(int r, int c) { const int st = (r >> 4) * 2 + (c >> 5), rr = r & 15, cc = c & 31, ob = rr * 64 + cc * 2; return st * 1024 + (ob ^ (((ob >> 9) & 1) << 5)); }
__host__ __device__ __forceinline__ void stage_rc(int b, int& R, int& C) { const int st = b / 1024, sb = b % 1024, swz = sb ^ (((sb >> 9) & 1) << 5); R = (st >> 1) * 16 + swz / 64; C = (st & 1) * 32 + (swz % 64) / 2; }
__host__ __device__ __forceinline__ int perm32(int rho) { const int n = rho >> 4, i = rho & 15; return 8 * (i >> 2) + 4 * n + (i & 3); }

struct Unit { const char* A; const char* B; int nt, pm, pn, mode; };

struct TileOrder {
    int nM, nN, nwg, G, c;
    __device__ void init(int nM_, int nN_, int G_, int c_) { nM = nM_; nN = nN_; nwg = nM * nN; G = G_; c = c_; }
    __device__ bool tile(int i, int& pm, int& pn) const {
        const long L = (long)i * G + c; if (L >= nwg) return false;
        int wgid = (int)L; { const int q = nwg / NXCD, r = nwg % NXCD, xcd = wgid % NXCD, off = wgid / NXCD; wgid = (xcd < r ? xcd * (q + 1) : r * (q + 1) + (xcd - r) * q) + off; }
        const int nig = WGM * nN, gid = wgid / nig, fm = gid * WGM, gsz = (nM - fm) < WGM ? (nM - fm) : WGM;
        pm = fm + ((wgid % nig) % gsz); pn = (wgid % nig) / gsz; return true;
    }
};

template <class Epi, class Sched, bool ALIGN_EPI>
__device__ __forceinline__ void gemm_phase(LAS unsigned char* lds, const int lda, const int ldb, const Sched& S, const Epi& E) {
    int tid_ = threadIdx.x; asm volatile("" : "+v"(tid_));
    const int tid = tid_, wid = __builtin_amdgcn_readfirstlane(tid >> 6), lane = tid & 63, wr = wid >> 2, wc = wid & 3, fr = lane & 15, fq = lane >> 4;
    unsigned voffA[2], voffB[2];
#pragma unroll
    for (int i = 0; i < 2; ++i) { int R, C; stage_rc(tid * 16 + i * 8192, R, C); const int Rb = Epi::PERM ? ((R & ~31) + perm32(R & 31)) : R;
        voffA[i] = (unsigned)(R * lda + C) * 2u; voffB[i] = (unsigned)(Rb * ldb + C) * 2u; }
    const size_t kstep = (size_t)(BK * 2);
    const size_t hstepA = (size_t)HALF * lda * 2, hstepB = (size_t)HALF * ldb * 2;
    const unsigned ldsw = (unsigned)wid * 1024u;
    const int aoff = lds_byte(wr * 64 + fr, fq * 8), boff = lds_byte(wc * 32 + fr, fq * 8);
#define PG8_SA(b, h) (((b) * 2 + (h)) * HTB)
#define PG8_SB(b, h) ((4 + (b) * 2 + (h)) * HTB)
#define PG8_STAGE(bufoff, gbase, voff) do { _Pragma("unroll") for (int _i = 0; _i < 2; ++_i) \
        __builtin_amdgcn_global_load_lds((const unsigned*)((const char*)(gbase) + (voff)[_i]), (LAS unsigned*)(lds + (bufoff) + ldsw + _i * 8192), 16, 0, 0); } while (0)
#define PG8_LDA(dst, b, h) do { _Pragma("unroll") for (int m = 0; m < 4; ++m) _Pragma("unroll") for (int k = 0; k < 2; ++k) dst[m][k] = *(const LAS h8*)(lds + PG8_SA(b, h) + aoff + m * 2048 + k * 1024); } while (0)
#define PG8_LDB(dst, b, h) do { _Pragma("unroll") for (int n = 0; n < 2; ++n) _Pragma("unroll") for (int k = 0; k < 2; ++k) dst[n][k] = *(const LAS h8*)(lds + PG8_SB(b, h) + boff + n * 2048 + k * 1024); } while (0)
#define PG8_MMA(ai, bj, At, Bt) do { __builtin_amdgcn_s_setprio(1); _Pragma("unroll") for (int m = 0; m < 4; ++m) _Pragma("unroll") for (int n = 0; n < 2; ++n) _Pragma("unroll") for (int k = 0; k < 2; ++k) \
        acc[ai][bj][m][n] = __builtin_amdgcn_mfma_f32_16x16x32_f16(Bt[n][k], At[m][k], acc[ai][bj][m][n], 0, 0, 0); __builtin_amdgcn_s_setprio(0); } while (0)
#define PG8_WAIT_V(n) asm volatile("s_waitcnt vmcnt(" #n ")" ::: "memory")
#define PG8_WAIT_L(n) asm volatile("s_waitcnt lgkmcnt(" #n ")" ::: "memory")
#define PG8_BAR __builtin_amdgcn_s_barrier()
#define PG8_SCHED __builtin_amdgcn_sched_barrier(0)
    Unit cur, nxt; int ui = 0;
    if (!S.next(0, cur)) return;
    f32x4 acc[2][2][4][2];
#pragma unroll
    for (int a = 0; a < 2; ++a)
#pragma unroll
        for (int b = 0; b < 2; ++b)
#pragma unroll
            for (int m = 0; m < 4; ++m)
#pragma unroll
                for (int n = 0; n < 2; ++n) acc[a][b][m][n] = (f32x4){0.f, 0.f, 0.f, 0.f};
    h8 At[4][2], B0[2][2], B1[2][2];
    const char* cA = cur.A; const char* cB = cur.B;
    PG8_STAGE(PG8_SB(0, 0), cB, voffB); PG8_STAGE(PG8_SB(0, 1), cB + hstepB, voffB); PG8_STAGE(PG8_SA(0, 0), cA, voffA); PG8_STAGE(PG8_SA(0, 1), cA + hstepA, voffA);
    if (wr == 1) PG8_BAR;
    PG8_WAIT_V(2); PG8_BAR;
    PG8_STAGE(PG8_SB(1, 0), cB + kstep, voffB); PG8_STAGE(PG8_SA(1, 0), cA + kstep, voffA); PG8_STAGE(PG8_SB(1, 1), cB + hstepB + kstep, voffB);
    PG8_WAIT_V(6); PG8_BAR;
    for (;;) {
        const bool has_next = S.next(ui + 1, nxt);
        const char* nA = has_next ? nxt.A : cA; const char* nB = has_next ? nxt.B : cB;
        const int nt = cur.nt;
        for (int t = 0; t < nt; t += 2) {
            const bool last = (t == nt - 2);
            const char* a1 = cA + (size_t)(t + 1) * kstep;
            const char* a2 = last ? nA : cA + (size_t)(t + 2) * kstep; const char* b2 = last ? nB : cB + (size_t)(t + 2) * kstep;
            const char* a3 = a2 + kstep; const char* b3 = b2 + kstep;
            PG8_LDB(B0, 0, 0); PG8_LDB(B1, 0, 1); PG8_SCHED; PG8_LDA(At, 0, 0); PG8_STAGE(PG8_SA(1, 1), a1 + hstepA, voffA);
            PG8_WAIT_V(8); PG8_WAIT_L(0); PG8_BAR; PG8_MMA(0, 0, At, B0); PG8_MMA(0, 1, At, B1); PG8_BAR; PG8_SCHED;
            PG8_LDA(At, 0, 1); PG8_STAGE(PG8_SB(0, 0), b2, voffB); PG8_STAGE(PG8_SB(0, 1), b2 + hstepB, voffB); PG8_STAGE(PG8_SA(0, 0), a2, voffA);
            PG8_WAIT_V(8); PG8_WAIT_L(0); PG8_BAR; PG8_MMA(1, 0, At, B0); PG8_MMA(1, 1, At, B1); PG8_BAR; PG8_SCHED;
            PG8_LDB(B0, 1, 0); PG8_LDB(B1, 1, 1); PG8_SCHED; PG8_LDA(At, 1, 0); PG8_STAGE(PG8_SA(0, 1), a2 + hstepA, voffA);
            PG8_WAIT_V(8); PG8_WAIT_L(0); PG8_BAR; PG8_MMA(0, 0, At, B0); PG8_MMA(0, 1, At, B1); PG8_BAR; PG8_SCHED;
            PG8_LDA(At, 1, 1); PG8_STAGE(PG8_SB(1, 0), b3, voffB); PG8_STAGE(PG8_SB(1, 1), b3 + hstepB, voffB); PG8_STAGE(PG8_SA(1, 0), a3, voffA);
            PG8_WAIT_V(8); PG8_WAIT_L(0); PG8_BAR; PG8_MMA(1, 0, At, B0); PG8_MMA(1, 1, At, B1); PG8_BAR; PG8_SCHED;
        }
        if constexpr (ALIGN_EPI) { if (wr == 0) PG8_BAR; }
        E(acc, cur, wr, wc, fr, fq);
        if (!has_next) break;
#pragma unroll
        for (int a = 0; a < 2; ++a)
#pragma unroll
            for (int b = 0; b < 2; ++b)
#pragma unroll
                for (int m = 0; m < 4; ++m)
#pragma unroll
                    for (int n = 0; n < 2; ++n) acc[a][b][m][n] = (f32x4){0.f, 0.f, 0.f, 0.f};
        cur = nxt; cA = nA; cB = nB; ++ui;
        if constexpr (ALIGN_EPI) { if (wr == 1) PG8_BAR; }
    }
    PG8_WAIT_V(0);
    if constexpr (!ALIGN_EPI) { if (wr == 0) PG8_BAR; }
    PG8_BAR;
#undef PG8_SA
#undef PG8_SB
#undef PG8_STAGE
#undef PG8_LDA
#undef PG8_LDB
#undef PG8_MMA
#undef PG8_WAIT_V
#undef PG8_WAIT_L
#undef PG8_BAR
#undef PG8_SCHED
}

struct EpiF16 {
    static constexpr bool PERM = true;
    f16* O; int ldc; int mode; const float* aux; float scale;
    __device__ __forceinline__ void operator()(const f32x4 (&acc)[2][2][4][2], const Unit& u, int wr, int wc, int fr, int fq) const {
        const int row0 = u.pm * BM + wr * 64 + fr;
#pragma unroll
        for (int bj = 0; bj < 2; ++bj) {
            const int cg32 = u.pn * BM + bj * HALF + wc * 32;
            const int col0 = cg32 + 8 * fq;
            const bool rope = (mode == 1) && ((cg32 % 96) == 64) && (u.pm >= 32);
            float cs[8];
            if (mode == 2) {
#pragma unroll
                for (int e = 0; e < 8; ++e) cs[e] = aux[col0 + e];
            }
#pragma unroll
            for (int ai = 0; ai < 2; ++ai)
#pragma unroll
                for (int m = 0; m < 4; ++m) {
                    const int row = row0 + ai * HALF + m * 16;
                    float v[8];
#pragma unroll
                    for (int n = 0; n < 2; ++n)
#pragma unroll
                        for (int e = 0; e < 4; ++e) v[4 * n + e] = acc[ai][bj][m][n][e];
                    if (mode == 1) {
                        if (rope) {
                            const int t = (row - NCTX) & (SEQL - 1);
                            const int pos = (fq < 2) ? (t >> 6) : (t & 63);
                            const float* tb = aux + pos * 16;
#pragma unroll
                            for (int e = 0; e < 8; ++e) {
                                const float other = __shfl_xor(v[e], 16);
                                const float c = tb[2 * e], s = tb[2 * e + 1];
                                v[e] = (fq & 1) ? (other * s + v[e] * c) : (v[e] * c - other * s);
                            }
                        }
#pragma unroll
                        for (int e = 0; e < 8; ++e) v[e] *= scale;
                    } else if (mode == 2) {
#pragma unroll
                        for (int e = 0; e < 8; ++e) v[e] *= cs[e];
                    }
                    u32x4 w; w.x = pk2h(v[0], v[1]); w.y = pk2h(v[2], v[3]); w.z = pk2h(v[4], v[5]); w.w = pk2h(v[6], v[7]);
                    *(u32x4*)(O + (size_t)row * ldc + col0) = w;
                }
        }
    }
};

struct EpiMerge {
    static constexpr bool PERM = true;
    unsigned char* scr; f16* merged;
    __device__ __forceinline__ void operator()(const f32x4 (&acc)[2][2][4][2], const Unit& u, int wr, int wc, int fr, int fq) const {
        int tid = (wr * 4 + wc) * 64 + fq * 16 + fr; asm volatile("" : "+v"(tid));
        const int row0 = u.pm * BM + wr * 64 + fr;
#pragma unroll
        for (int ai = 0; ai < 2; ++ai)
#pragma unroll
            for (int bj = 0; bj < 2; ++bj)
#pragma unroll
                for (int m = 0; m < 4; ++m) {
                    const int idx = (ai * 2 + bj) * 4 + m;
                    u32x4* sp = (u32x4*)(scr + ((size_t)idx * NTHREADS + tid) * 16);
                    float v[8];
#pragma unroll
                    for (int n = 0; n < 2; ++n)
#pragma unroll
                        for (int e = 0; e < 4; ++e) v[4 * n + e] = acc[ai][bj][m][n][e];
                    if ((u.mode & 1) == 0) {
#pragma unroll
                        for (int e = 0; e < 8; ++e) v[e] = sigmoidf_(v[e]);
                        u32x4 w; w.x = pk2h(v[0], v[1]); w.y = pk2h(v[2], v[3]); w.z = pk2h(v[4], v[5]); w.w = pk2h(v[6], v[7]);
                        *sp = w;
                    } else {
                        const u32x4 g = *sp;
                        v[0] *= h_lo(g.x); v[1] *= h_hi(g.x); v[2] *= h_lo(g.y); v[3] *= h_hi(g.y); v[4] *= h_lo(g.z); v[5] *= h_hi(g.z); v[6] *= h_lo(g.w); v[7] *= h_hi(g.w);
                        const int row = row0 + ai * HALF + m * 16, col0 = u.pn * BM + bj * HALF + wc * 32 + 8 * fq;
                        u32x4* mp = (u32x4*)(merged + (size_t)row * DM + col0);
                        if (u.mode != 1) {
                            const u32x4 o = *mp;
                            v[0] += h_lo(o.x); v[1] += h_hi(o.x); v[2] += h_lo(o.y); v[3] += h_hi(o.y); v[4] += h_lo(o.z); v[5] += h_hi(o.z); v[6] += h_lo(o.w); v[7] += h_hi(o.w);
                        }
                        u32x4 w; w.x = pk2h(v[0], v[1]); w.y = pk2h(v[2], v[3]); w.z = pk2h(v[4], v[5]); w.w = pk2h(v[6], v[7]);
                        *mp = w;
                    }
                }
    }
};

struct EpiRes {
    static constexpr bool PERM = false;
    const float* srcP; const float* srcS;
    float* out; const float* gate;
    __device__ __forceinline__ void operator()(const f32x4 (&acc)[2][2][4][2], const Unit& u, int wr, int wc, int fr, int fq) const {
        const int cls = u.pm < 32 ? 0 : (u.pm < 48 ? 1 : 2);
        const float* src = u.pm < 32 ? srcP + (size_t)u.pm * BM * DM : srcS + (size_t)(u.pm - 32) * BM * DM;
        float* dst = out + (size_t)u.pm * BM * DM;
        const int col0 = u.pn * BM + wc * 32 + 4 * fq;
#pragma unroll
        for (int bj = 0; bj < 2; ++bj)
#pragma unroll
            for (int n = 0; n < 2; ++n) {
                const int col = col0 + bj * HALF + n * 16;
                const f32x4 gv = *(const f32x4*)(gate + cls * NMOD + col);
#pragma unroll
                for (int ai = 0; ai < 2; ++ai)
#pragma unroll
                    for (int m = 0; m < 4; ++m) {
                        const size_t off = (size_t)(ai * HALF + wr * 64 + m * 16 + fr) * DM + col;
                        const f32x4 s = *(const f32x4*)(src + off);
                        *(f32x4*)(dst + off) = s + gv * acc[ai][bj][m][n];
                    }
            }
    }
};

struct EpiUp {
    static constexpr bool PERM = true;
    f16* act; float* edge; float* vedge; const float* convw; const float* convb;
    __device__ __forceinline__ void operator()(const f32x4 (&acc)[2][2][4][2], const Unit& u, int wr, int wc, int fr, int fq) const {
        const int j0 = u.pn * 128 + wc * 32 + 8 * fq;
#pragma unroll
        for (int n = 0; n < 2; ++n) {
            const f32x4 w0 = *(const f32x4*)(convw + j0 + 4 * n), w1 = *(const f32x4*)(convw + DFF + j0 + 4 * n), w2 = *(const f32x4*)(convw + 2 * DFF + j0 + 4 * n), cb = *(const f32x4*)(convb + j0 + 4 * n);
#pragma unroll
            for (int ai = 0; ai < 2; ++ai) {
                const int chunk = u.pm * 4 + ai * 2 + wr;
                const int rowc = u.pm * BM + ai * HALF + wr * 64;
#pragma unroll
                for (int m = 0; m < 4; ++m) {
                    const f32x4 cur = acc[ai][0][m][n], val = acc[ai][1][m][n];
                    const f32x4 up = acc[ai][0][m > 0 ? m - 1 : 0][n], dn = acc[ai][0][m < 3 ? m + 1 : 3][n];
                    f32x4 pv, nv;
#pragma unroll
                    for (int e = 0; e < 4; ++e) {
                        const float selp = (fr == 15) ? up[e] : cur[e];
                        const float seln = (fr == 0) ? dn[e] : cur[e];
                        pv[e] = __builtin_bit_cast(float, __builtin_amdgcn_update_dpp(0, __builtin_bit_cast(int, selp), 0x121, 0xf, 0xf, false));
                        nv[e] = __builtin_bit_cast(float, __builtin_amdgcn_update_dpp(0, __builtin_bit_cast(int, seln), 0x12F, 0xf, 0xf, false));
                    }
                    const int i = m * 16 + fr;
                    const int row = rowc + i;
                    f32x4 g = w0 * pv + w1 * cur + w2 * nv + cb;
                    float a[4];
#pragma unroll
                    for (int e = 0; e < 4; ++e) a[e] = siluf_(g[e]) * val[e];
                    if (i != 0 && i != 63) {
                        u32x2 w; w.x = pk2h(a[0], a[1]); w.y = pk2h(a[2], a[3]);
                        *(u32x2*)(act + (size_t)row * DFF + j0 + 4 * n) = w;
                    }
                    if (m == 0 && fr < 2) *(f32x4*)(edge + ((size_t)chunk * 4 + fr) * DFF + j0 + 4 * n) = cur;
                    if (m == 3 && fr >= 14) *(f32x4*)(edge + ((size_t)chunk * 4 + (fr - 12)) * DFF + j0 + 4 * n) = cur;
                    if (m == 0 && fr == 0) *(f32x4*)(vedge + ((size_t)chunk * 2 + 0) * DFF + j0 + 4 * n) = val;
                    if (m == 3 && fr == 15) *(f32x4*)(vedge + ((size_t)chunk * 2 + 1) * DFF + j0 + 4 * n) = val;
                }
            }
        }
    }
};

struct SchedPlain {
    TileOrder T; const char* A; const char* B; int lda, ldb, nt, koff;
    __device__ __forceinline__ bool next(int i, Unit& u) const {
        int pm, pn; if (!T.tile(i, pm, pn)) return false;
        u.A = A + ((size_t)pm * BM * lda + (size_t)pn * koff) * 2; u.B = B + ((size_t)pn * BM * ldb + (size_t)pn * koff) * 2; u.nt = nt; u.pm = pm; u.pn = pn; u.mode = 0; return true;
    }
};
struct SchedMerge {
    TileOrder T; const char* Hh; const char* ABO; const char* CO; const char* Wg; const char* Wab; const char* Wc;
    __device__ __forceinline__ bool next(int i, Unit& u) const {
        int pm, pn; if (!T.tile(i / 6, pm, pn)) return false;
        const int sub = i % 6, br = sub >> 1;
        u.pm = pm; u.pn = pn; u.mode = sub;
        if ((sub & 1) == 0) { u.A = Hh + (size_t)pm * BM * 1024 * 2; u.B = Wg + ((size_t)(br * 1024 + pn * BM) * 1024) * 2; u.nt = 16; }
        else if (br < 2)    { u.A = ABO + ((size_t)pm * BM * 1024 + br * 512) * 2; u.B = Wab + ((size_t)pn * BM * 1024 + br * 512) * 2; u.nt = 8; }
        else                { u.A = CO + (size_t)pm * BM * 1024 * 2; u.B = Wc + (size_t)pn * BM * 1024 * 2; u.nt = 8; }
        return true;
    }
};
}

namespace attn {
constexpr int NSLOT = 3, A_KSZ = 12288, A_VSZ = 8192, A_K0 = 0, A_V0 = NSLOT * A_KSZ, A_WSF = A_V0 + NSLOT * A_VSZ, A_OST = A_WSF + 2048, A_END = A_OST + 8 * 4096;
static_assert(A_END <= RING_BYTES, "attention LDS");
constexpr float THR = 6.0f;
__device__ __forceinline__ int crow(int r, int hi) { return (r & 3) + 8 * (r >> 2) + 4 * hi; }

struct Src { const f16* K1; int k1p; const f16* K2; int k2p; const f16* V; int vp; };

#define AT_WAIT(n) asm volatile("s_waitcnt vmcnt(" #n ")" ::: "memory")
template <int DQK>
__device__ __forceinline__ void unit(LAS unsigned char* lds, const f16* Q, int qp, const Src s, int ntiles, f16* O, int op) {
    constexpr int ND = DQK / 16;
    int tid_ = threadIdx.x; asm volatile("" : "+v"(tid_));
    const int tid = tid_, lane = tid & 63, r32 = lane & 31, hi = lane >> 5;
    const int wid = __builtin_amdgcn_readfirstlane(tid >> 6);
    LAS float* wsf = (LAS float*)(lds + A_WSF) + wid * 64;
    const f16* ksrc = s.K1 + (size_t)lane * s.k1p + wid * 8;
    const f16* k2src = (DQK == 96) ? s.K2 + (size_t)lane * s.k2p + (wid & 3) * 8 : nullptr;
    const f16* vsrc = s.V + (size_t)(16 * (wid & 3) + (lane >> 2)) * s.vp + (wid >> 2) * 32 + (lane & 3) * 8;
    const size_t kst = (size_t)64 * s.k1p, k2st = (size_t)64 * s.k2p, vst = (size_t)64 * s.vp;
    const bool rope_w = (DQK == 96) && (wid < 4);
#define AT_DMA(t, slot) do { \
        __builtin_amdgcn_global_load_lds((const unsigned*)(ksrc + (size_t)(t) * kst), (LAS unsigned*)(lds + A_K0 + (slot) * A_KSZ + wid * 1024), 16, 0, 0); \
        if (rope_w) __builtin_amdgcn_global_load_lds((const unsigned*)(k2src + (size_t)(t) * k2st), (LAS unsigned*)(lds + A_K0 + (slot) * A_KSZ + (8 + wid) * 1024), 16, 0, 0); \
        __builtin_amdgcn_global_load_lds((const unsigned*)(vsrc + (size_t)(t) * vst), (LAS unsigned*)(lds + A_V0 + (slot) * A_VSZ + wid * 1024), 16, 0, 0); } while (0)
    h8 qf[ND];
    { const f16* qw = Q + (size_t)(wid * 32 + r32) * qp + hi * 8;
#pragma unroll
      for (int d0 = 0; d0 < ND; ++d0) qf[d0] = *(const h8*)(qw + d0 * 16); }
    AT_DMA(0, 0);
    if (ntiles > 1) AT_DMA(1, 1);
    float m_run = 0.f, l_run = 0.f;
    f32x16 o0 = {}, o1 = {}, negm = {};
    const int vrd = ((lane >> 4) & 1) * 32 + (lane & 3) * 8 + (4 * hi + ((lane & 15) >> 2)) * 64;
    int slot = 0;
    typedef short s16x8 __attribute__((ext_vector_type(8)));
    for (int t = 0; t < ntiles; ++t) {
        if (t + 1 < ntiles) { if (rope_w) AT_WAIT(3); else AT_WAIT(2); } else AT_WAIT(0);
        __builtin_amdgcn_s_barrier();
        asm volatile("" ::: "memory");
        if (t + 2 < ntiles) { const int s2 = slot == 0 ? 2 : slot - 1; AT_DMA(t + 2, s2); }
        const int kb = A_K0 + slot * A_KSZ, vb = A_V0 + slot * A_VSZ;
        h8 kf[2 * ND]; s16x4 vl[8], vh[8];
        { const LAS unsigned char* kp = lds + kb + hi * 1024 + r32 * 16;
#pragma unroll
          for (int d0 = 0; d0 < ND; ++d0) { kf[2 * d0] = *(const LAS h8*)(kp + d0 * 2048); kf[2 * d0 + 1] = *(const LAS h8*)(kp + d0 * 2048 + 512); }
          const LAS unsigned char* vp = lds + vb + vrd;
#pragma unroll
          for (int i = 0; i < 8; ++i) {
              vl[i] = __builtin_amdgcn_ds_read_tr16_b64_v4i16((LAS s16x4*)(vp + (i >> 2) * 4096 + (i & 3) * 1024));
              vh[i] = __builtin_amdgcn_ds_read_tr16_b64_v4i16((LAS s16x4*)(vp + (i >> 2) * 4096 + (i & 3) * 1024 + 512));
          } }
        __builtin_amdgcn_sched_barrier(0);
        f32x16 p0, p1;
        __builtin_amdgcn_s_setprio(1);
#pragma unroll
        for (int d0 = 0; d0 < ND; ++d0) {
            p0 = __builtin_amdgcn_mfma_f32_32x32x16_f16(kf[2 * d0], qf[d0], d0 == 0 ? negm : p0, 0, 0, 0);
            p1 = __builtin_amdgcn_mfma_f32_32x32x16_f16(kf[2 * d0 + 1], qf[d0], d0 == 0 ? negm : p1, 0, 0, 0);
        }
        __builtin_amdgcn_s_setprio(0);
        float ma = fmaxf(fmaxf(p0[0], p0[1]), p1[0]), mb = fmaxf(fmaxf(p0[2], p0[3]), p1[1]);
        ma = fmaxf(fmaxf(ma, p1[2]), p1[3]);
#pragma unroll
        for (int r = 4; r < 16; r += 4) { ma = fmaxf(fmaxf(ma, p0[r]), p0[r + 1]); mb = fmaxf(fmaxf(mb, p0[r + 2]), p0[r + 3]); ma = fmaxf(fmaxf(ma, p1[r]), p1[r + 1]); mb = fmaxf(fmaxf(mb, p1[r + 2]), p1[r + 3]); }
        float mt = fmaxf(ma, mb);
        mt = fmaxf(mt, __shfl_xor(mt, 32));
        const bool first = (t == 0);
        if (first || __any(mt > THR)) {
            const float dl = first ? mt : (mt > THR ? mt : 0.f);
            m_run += dl;
#pragma unroll
            for (int r = 0; r < 16; ++r) { p0[r] -= dl; p1[r] -= dl; negm[r] = -m_run; }
            if (!first) {
                const float alpha = fast_exp2(-dl);
                l_run *= alpha;
                if (hi == 0) wsf[r32] = alpha;
                __builtin_amdgcn_wave_barrier();
#pragma unroll
                for (int r = 0; r < 16; ++r) { const float a = wsf[crow(r, hi)]; o0[r] *= a; o1[r] *= a; }
                __builtin_amdgcn_wave_barrier();
            }
        }
        float ls = 0.f;
#pragma unroll
        for (int r = 0; r < 16; ++r) { p0[r] = fast_exp2(p0[r]); p1[r] = fast_exp2(p1[r]); ls += p0[r] + p1[r]; }
        l_run += ls;
        u32x4 pw[4];
#define AT_PK(a, b) __builtin_bit_cast(unsigned, __builtin_amdgcn_cvt_pkrtz((a), (b)))
#pragma unroll
        for (int q = 0; q < 2; ++q) {
            pw[q] = (u32x4){AT_PK(p0[8 * q], p0[8 * q + 1]), AT_PK(p0[8 * q + 2], p0[8 * q + 3]), AT_PK(p0[8 * q + 4], p0[8 * q + 5]), AT_PK(p0[8 * q + 6], p0[8 * q + 7])};
            pw[2 + q] = (u32x4){AT_PK(p1[8 * q], p1[8 * q + 1]), AT_PK(p1[8 * q + 2], p1[8 * q + 3]), AT_PK(p1[8 * q + 4], p1[8 * q + 5]), AT_PK(p1[8 * q + 6], p1[8 * q + 7])};
        }
#undef AT_PK
        __builtin_amdgcn_s_setprio(1);
#pragma unroll
        for (int ks = 0; ks < 4; ++ks) {
            const s16x8 va = {vl[ks][0], vl[ks][1], vl[ks][2], vl[ks][3], vh[ks][0], vh[ks][1], vh[ks][2], vh[ks][3]};
            const s16x8 vb8 = {vl[4 + ks][0], vl[4 + ks][1], vl[4 + ks][2], vl[4 + ks][3], vh[4 + ks][0], vh[4 + ks][1], vh[4 + ks][2], vh[4 + ks][3]};
            const h8 pa = __builtin_bit_cast(h8, pw[ks]);
            o0 = __builtin_amdgcn_mfma_f32_32x32x16_f16(pa, __builtin_bit_cast(h8, va), o0, 0, 0, 0);
            o1 = __builtin_amdgcn_mfma_f32_32x32x16_f16(pa, __builtin_bit_cast(h8, vb8), o1, 0, 0, 0);
        }
        __builtin_amdgcn_s_setprio(0);
        slot = slot == 2 ? 0 : slot + 1;
    }
    l_run += __shfl_xor(l_run, 32);
    if (hi == 0) wsf[32 + r32] = l_run;
    __builtin_amdgcn_wave_barrier();
    LAS f16* stg = (LAS f16*)(lds + A_OST) + wid * 2048;
#pragma unroll
    for (int r = 0; r < 16; ++r) {
        const int orow = crow(r, hi); const float rl = 1.0f / wsf[32 + orow];
        stg[orow * 64 + r32] = (f16)(o0[r] * rl); stg[orow * 64 + 32 + r32] = (f16)(o1[r] * rl);
    }
    __builtin_amdgcn_wave_barrier();
    f16* ow = O + (size_t)(wid * 32) * op;
#pragma unroll
    for (int i = 0; i < 4; ++i) { const int row = i * 8 + (lane >> 3), ch = lane & 7; const u32x4 v = *(const LAS u32x4*)(stg + row * 64 + ch * 8); *(u32x4*)(ow + (size_t)row * op + ch * 8) = v; }
    asm volatile("s_waitcnt lgkmcnt(0)" ::: "memory");
    __builtin_amdgcn_s_barrier();
    asm volatile("" ::: "memory");
#undef AT_DMA
}
#undef AT_WAIT
}

struct Frame {
    LAS unsigned char* lds;
    int tid, lane, wave, vcu, G;
    unsigned char* ws; float* out;
};

#if !USE_CG
#define XB_TMO      128
#define XB_XCNT(j)  (256  + 64 * (j))
#define XB_XSUB(j)  (1280 + 64 * (j))
#define XB_XGEN(j)  (2304 + 64 * (j))
#define XB_TOP      3328
#define XB_TOPGEN   3392
#define XCD_BAR_WORDS 3456
#define XB_SPIN_CAP (1u << 18)
__device__ __forceinline__ unsigned xb_ld(unsigned* p)              { return __hip_atomic_load(p, __ATOMIC_RELAXED, __HIP_MEMORY_SCOPE_AGENT); }
__device__ __forceinline__ unsigned xb_add(unsigned* p, unsigned v) { return __hip_atomic_fetch_add(p, v, __ATOMIC_RELAXED, __HIP_MEMORY_SCOPE_AGENT); }
__device__ __forceinline__ unsigned xb_xcc_id() { return (unsigned)__builtin_amdgcn_s_getreg((3 << 11) | 20) & 0xFu; }
#define XB_SPIN(cond, bar) do { unsigned _sp = 0; while (cond) { __builtin_amdgcn_s_sleep(1); \
    if ((++_sp & 255u) == 0u) { if (xb_ld(&(bar)[XB_TMO])) break; if (_sp > XB_SPIN_CAP) { atomicAdd(&(bar)[XB_TMO], 1u); break; } } } } while (0)
struct XcdBarrier { unsigned* bar; unsigned x; volatile LAS unsigned* st; };
__device__ __forceinline__ XcdBarrier xcd_barrier_post(unsigned* bar, volatile LAS unsigned* st) {
    XcdBarrier b; b.bar = bar; b.x = xb_xcc_id(); b.st = st;
    if (threadIdx.x == 0) (void)xb_add(&bar[XB_XCNT(b.x)], 1u);
    return b;
}
__device__ __forceinline__ void xcd_barrier_complete(unsigned* bar, unsigned x, unsigned& nloc, unsigned& nx) {
    const unsigned G = gridDim.x * gridDim.y * gridDim.z;
    unsigned sum, cnt, mine, sp = 0u;
    for (;;) {
        sum = 0u; cnt = 0u; mine = 0u;
#pragma unroll
        for (unsigned j = 0; j < 16; ++j) { const unsigned c = xb_ld(&bar[XB_XCNT(j)]); sum += c; cnt += (c > 0u) ? 1u : 0u; mine = (j == x) ? c : mine; }
        if (sum == G) break;
        __builtin_amdgcn_s_sleep(1);
        if ((++sp & 255u) == 0u) { if (xb_ld(&bar[XB_TMO])) break; if (sp > XB_SPIN_CAP) { atomicAdd(&bar[XB_TMO], 1u); break; } }
    }
    nloc = mine > 0u ? mine : 1u; nx = cnt > 0u ? cnt : 1u;
}
__device__ __forceinline__ void xcd_barrier(const XcdBarrier& b) {
    asm volatile("s_waitcnt vmcnt(0)" ::: "memory");
    __syncthreads();
    if (threadIdx.x == 0) {
        unsigned* bar = b.bar;
        __builtin_amdgcn_s_waitcnt(0);
        unsigned nloc = b.st[0], nx = b.st[1];
        if (nloc == 0u) { xcd_barrier_complete(bar, b.x, nloc, nx); b.st[0] = nloc; b.st[1] = nx; }
        const unsigned old = xb_add(&bar[XB_XSUB(b.x)], 1u);
        const unsigned gen = old / nloc;
        if (old + 1u == (gen + 1u) * nloc) {
            __builtin_amdgcn_fence(__ATOMIC_RELEASE, "agent");
            asm volatile("s_waitcnt vmcnt(0)" ::: "memory");
            const unsigned og = xb_add(&bar[XB_TOP], 1u);
            const unsigned tg = og / nx;
            if (og + 1u == (tg + 1u) * nx) xb_add(&bar[XB_TOPGEN], 1u);
            else XB_SPIN(xb_ld(&bar[XB_TOPGEN]) == tg, bar);
            __builtin_amdgcn_fence(__ATOMIC_ACQUIRE, "agent");
            xb_add(&bar[XB_XGEN(b.x)], 1u);
            asm volatile("s_waitcnt vmcnt(0)" ::: "memory");
        } else {
            XB_SPIN(xb_ld(&bar[XB_XGEN(b.x)]) == gen, bar);
            __builtin_amdgcn_fence(__ATOMIC_ACQUIRE, "agent");
            asm volatile("s_waitcnt vmcnt(0)" ::: "memory");
        }
    }
    __syncthreads();
}
#endif

__device__ __forceinline__ void transpose_item(const float* W, int N, f16* WT, int dpitch, int drow0, int koff, LAS float* scr, int k0, int n0, int lane) {
#pragma unroll 8
    for (int i = 0; i < 32; ++i) { const int kk = 2 * i + (lane >> 5); scr[kk * 33 + (lane & 31)] = W[(size_t)(k0 + kk) * N + n0 + (lane & 31)]; }
    asm volatile("s_waitcnt lgkmcnt(0)" ::: "memory");
    const int c = lane & 7;
#pragma unroll
    for (int j = 0; j < 4; ++j) { const int n = (lane >> 3) + 8 * j; const LAS float* s = scr + (8 * c) * 33 + n;
        u32x4 o; o.x = pk2h(s[0 * 33], s[1 * 33]); o.y = pk2h(s[2 * 33], s[3 * 33]); o.z = pk2h(s[4 * 33], s[5 * 33]); o.w = pk2h(s[6 * 33], s[7 * 33]);
        *(u32x4*)(WT + (size_t)(drow0 + n) * dpitch + koff + k0 + 8 * c) = o; }
    asm volatile("s_waitcnt lgkmcnt(0)" ::: "memory");
}

constexpr int IT_IN = 16 * 53, IT_G = 16 * 96, IT_QB = 4 * 24, IT_KVB = 2 * 32, IT_POOL = 4 * 2 * 4, IT_BRA = 8 * 32, IT_BRB = 8 * 32, IT_BRC = 8 * 32, IT_OUT = 16 * 32, IT_UP = 16 * 176, IT_DOWN = 44 * 32;
constexpr int IT_LAYER = IT_IN + IT_G + IT_QB + IT_KVB + IT_POOL + IT_BRA + IT_BRB + IT_BRC + IT_OUT + IT_UP + IT_DOWN;

__device__ __forceinline__ void p0_convert(const Frame& F_, const Params& p) {
    Frame F = F_; { int t_ = threadIdx.x; asm volatile("" : "+v"(t_)); F.tid = t_; F.lane = t_ & 63; F.wave = __builtin_amdgcn_readfirstlane(t_ >> 6); }
    LAS float* scr = (LAS float*)(F.lds + F.wave * 16384);
    const int gw = F.vcu * NWAVES + F.wave, NGW = F.G * NWAVES;
    for (int it = gw; it < 2 * IT_LAYER; it += NGW) {
        const int l = it / IT_LAYER; int r = it % IT_LAYER;
        unsigned char* wl = F.ws + WS_W + (size_t)l * WL_BYTES;
        if (r < IT_IN) { const int kb = r / 53, nb = r % 53; transpose_item(p.in[11] + (size_t)l * 1024 * 4768, 4768, (f16*)(wl + WO_IN), 1024, 32 * nb, 0, scr, 64 * kb, 32 * nb, F.lane); continue; } r -= IT_IN;
        if (r < IT_G) { const int kb = r / 96, nb = r % 96; transpose_item(p.in[11] + (size_t)l * 1024 * 4768, 4768, (f16*)(wl + WO_G), 1024, 32 * nb, 0, scr, 64 * kb, 1696 + 32 * nb, F.lane); continue; } r -= IT_G;
        if (r < IT_QB) { const int kb = r / 24, nb = r % 24; transpose_item(p.in[13] + (size_t)l * 256 * 768, 768, (f16*)(wl + WO_QB), 256, 32 * nb, 0, scr, 64 * kb, 32 * nb, F.lane); continue; } r -= IT_QB;
        if (r < IT_KVB) { const int kb = r / 32, nb = r % 32; transpose_item(p.in[15] + (size_t)l * 128 * 1024, 1024, (f16*)(wl + WO_KVB), 128, 32 * nb, 0, scr, 64 * kb, 32 * nb, F.lane); continue; } r -= IT_KVB;
        if (r < IT_POOL) { const int g = r / 8, kb = (r % 8) / 4, nb = r % 4; transpose_item(p.in[18] + ((size_t)l * 4 + g) * 128 * 128, 128, (f16*)(wl + WO_POOL), 512, g * 128 + 32 * nb, g * 128, scr, 64 * kb, 32 * nb, F.lane); continue; } r -= IT_POOL;
        if (r < IT_BRA) { const int kb = r / 32, nb = r % 32; transpose_item(p.in[20] + (size_t)l * 512 * 1024, 1024, (f16*)(wl + WO_BRAB), 1024, 32 * nb, 0, scr, 64 * kb, 32 * nb, F.lane); continue; } r -= IT_BRA;
        if (r < IT_BRB) { const int kb = r / 32, nb = r % 32; transpose_item(p.in[21] + (size_t)l * 512 * 1024, 1024, (f16*)(wl + WO_BRAB), 1024, 32 * nb, 512, scr, 64 * kb, 32 * nb, F.lane); continue; } r -= IT_BRB;
        if (r < IT_BRC) { const int kb = r / 32, nb = r % 32; transpose_item(p.in[22] + (size_t)l * 512 * 1024, 1024, (f16*)(wl + WO_BRC), 1024, 32 * nb, 0, scr, 64 * kb, 32 * nb, F.lane); continue; } r -= IT_BRC;
        if (r < IT_OUT) { const int kb = r / 32, nb = r % 32; transpose_item(p.in[23] + (size_t)l * 1024 * 1024, 1024, (f16*)(wl + WO_OUT), 1024, 32 * nb, 0, scr, 64 * kb, 32 * nb, F.lane); continue; } r -= IT_OUT;
        if (r < IT_UP) { const int kb = r / 176, nb = r % 176; const int n0 = 32 * nb; const int j = n0 < DFF ? n0 : n0 - DFF; const int drow = (j / 128) * 256 + (n0 < DFF ? 0 : 128) + (j % 128);
            transpose_item(p.in[25] + (size_t)l * 1024 * 5632, 5632, (f16*)(wl + WO_UP), 1024, drow, 0, scr, 64 * kb, n0, F.lane); continue; } r -= IT_UP;
        { const int kb = r / 32, nb = r % 32; transpose_item(p.in[28] + (size_t)l * 2816 * 1024, 1024, (f16*)(wl + WO_DOWN), 2816, 32 * nb, 0, scr, 64 * kb, 32 * nb, F.lane); }
    }
    const int gt = F.vcu * NTHREADS + F.tid, NGT = F.G * NTHREADS;
    for (int l = 0; l < 2; ++l) {
        unsigned char* wl = F.ws + WS_W + (size_t)l * WL_BYTES;
        u32x4* z1 = (u32x4*)(wl + WO_IN + (size_t)1696 * 1024 * 2);
        for (int i = gt; i < 96 * 1024 * 2 / 16; i += NGT) z1[i] = (u32x4){0u, 0u, 0u, 0u};
        for (int i = gt; i < 512 * 512 / 8; i += NGT) { const int n = i / 64, k8 = i % 64; if ((n >> 7) != (k8 >> 4)) *(u32x4*)(wl + WO_POOL + ((size_t)n * 512 + k8 * 8) * 2) = (u32x4){0u, 0u, 0u, 0u}; }
    }
}

__device__ __forceinline__ void p0_mod(const Frame& F_, const Params& p) {
    Frame F = F_; { int t_ = threadIdx.x; asm volatile("" : "+v"(t_)); F.tid = t_; F.lane = t_ & 63; F.wave = __builtin_amdgcn_readfirstlane(t_ >> 6); }
    LAS float* red = (LAS float*)(F.lds);
    float* modf = (float*)(F.ws + WS_CTL + CTL_MOD);
    for (int it = F.vcu; it < 2 * 96; it += F.G) {
        const int l = it / 96, c0 = (it % 96) * 64;
        const float* W = p.in[8] + (size_t)l * 1024 * NMOD + c0 + F.lane;
        float a0 = 0.f, a1 = 0.f, a2 = 0.f;
        const int kb = F.wave * 128;
#pragma unroll 8
        for (int k = 0; k < 128; ++k) {
            const float w = W[(size_t)(kb + k) * NMOD];
            const float x0 = p.in[7][kb + k], x1 = p.in[2][kb + k], x2 = p.in[2][1024 + kb + k];
            a0 += siluf_(x0) * w; a1 += siluf_(x1) * w; a2 += siluf_(x2) * w;
        }
        __syncthreads();
        red[(F.wave * 3 + 0) * 64 + F.lane] = a0; red[(F.wave * 3 + 1) * 64 + F.lane] = a1; red[(F.wave * 3 + 2) * 64 + F.lane] = a2;
        __syncthreads();
        if (F.tid < 192) {
            const int j = F.tid / 64, c = F.tid % 64; float s = 0.f;
#pragma unroll
            for (int w = 0; w < 8; ++w) s += red[(w * 3 + j) * 64 + c];
            modf[((size_t)l * 3 + j) * NMOD + c0 + c] = s + p.in[9][(size_t)l * NMOD + c0 + c];
        }
    }
    __syncthreads();
}

__device__ __forceinline__ void p0_tables(const Frame& F_) {
    Frame F = F_; F.tid = threadIdx.x;
    if (F.vcu != F.G - 1) return;
    float* tm = (float*)(F.ws + WS_CTL + CTL_TABM); float* tg = (float*)(F.ws + WS_CTL + CTL_TABG);
    for (int e = F.tid; e < 64 * 8 + 64 * 16; e += NTHREADS) {
        const bool isg = e >= 512; const int ee = isg ? e - 512 : e; const int nf = isg ? 16 : 8; const int pos = ee / nf, i = ee % nf;
        const float fr32 = exp2f(-13.287712379549449f * (float)(2 * i) / (float)(2 * nf));
        const float ang = (float)pos * fr32;
        double x = (double)ang; const double twopi = 6.283185307179586476925286766559;
        const double kq = __builtin_floor(x / twopi + 0.5); x -= kq * twopi;
        double x2 = x * x, cs = 1.0, sn = x, tc = 1.0, ts = x;
#pragma unroll 1
        for (int n = 1; n <= 14; ++n) { tc *= -x2 / (double)((2 * n - 1) * (2 * n)); ts *= -x2 / (double)((2 * n) * (2 * n + 1)); cs += tc; sn += ts; }
        float* dst = isg ? tg + (size_t)ee * 2 : tm + (size_t)ee * 2;
        dst[0] = (float)cs; dst[1] = (float)sn;
    }
}

__device__ __forceinline__ void norm_mod_phase(const Frame& F_, const float* srcP, const float* srcS, const float* g, const float* modsh, const float* modsc, f16* H) {
    Frame F = F_; { int t_ = threadIdx.x; asm volatile("" : "+v"(t_)); F.tid = t_; F.lane = t_ & 63; F.wave = __builtin_amdgcn_readfirstlane(t_ >> 6); }
    const int gw = F.vcu * NWAVES + F.wave, NGW = F.G * NWAVES;
    for (int row = gw; row < NTOK; row += NGW) {
        const float* xr = row < NCTX ? srcP + (size_t)row * DM : srcS + (size_t)(row - NCTX) * DM;
        const int cls = mod_class(row);
        f32x4 v[4]; float s = 0.f;
#pragma unroll
        for (int j = 0; j < 4; ++j) { v[j] = *(const f32x4*)(xr + 4 * F.lane + 256 * j); s += (v[j].x * v[j].x + v[j].y * v[j].y) + (v[j].z * v[j].z + v[j].w * v[j].w); }
        const float rstd = 1.0f / sqrtf(wave_sum(s) * (1.0f / DM) + RMS_EPS);
#pragma unroll
        for (int j = 0; j < 4; ++j) {
            const int c = 4 * F.lane + 256 * j;
            const f32x4 gg = *(const f32x4*)(g + c), sc = *(const f32x4*)(modsc + cls * NMOD + c), sh = *(const f32x4*)(modsh + cls * NMOD + c);
            const f32x4 o = v[j] * rstd * gg * (sc + 1.0f) + sh;
            u32x2 w; w.x = pk2h(o.x, o.y); w.y = pk2h(o.z, o.w);
            *(u32x2*)(H + (size_t)row * DM + c) = w;
        }
    }
}
__device__ __forceinline__ void final_norm_phase(const Frame& F_, float* X, const float* g) {
    Frame F = F_; { int t_ = threadIdx.x; asm volatile("" : "+v"(t_)); F.tid = t_; F.lane = t_ & 63; F.wave = __builtin_amdgcn_readfirstlane(t_ >> 6); }
    const int gw = F.vcu * NWAVES + F.wave, NGW = F.G * NWAVES;
    for (int row = gw; row < NTOK; row += NGW) {
        float* xr = X + (size_t)row * DM;
        f32x4 v[4]; float s = 0.f;
#pragma unroll
        for (int j = 0; j < 4; ++j) { v[j] = *(const f32x4*)(xr + 4 * F.lane + 256 * j); s += (v[j].x * v[j].x + v[j].y * v[j].y) + (v[j].z * v[j].z + v[j].w * v[j].w); }
        const float rstd = 1.0f / sqrtf(wave_sum(s) * (1.0f / DM) + RMS_EPS);
#pragma unroll
        for (int j = 0; j < 4; ++j) { const int c = 4 * F.lane + 256 * j; *(f32x4*)(xr + c) = v[j] * rstd * *(const f32x4*)(g + c); }
    }
}

__device__ __forceinline__ void token_phase(const Frame& F_, const Params& p, int l) {
    Frame F = F_; { int t_ = threadIdx.x; asm volatile("" : "+v"(t_)); F.tid = t_; F.lane = t_ & 63; F.wave = __builtin_amdgcn_readfirstlane(t_ >> 6); }
    const f16* Z = (const f16*)(F.ws + WS_ZS);
    f16* QA = (f16*)(F.ws + WS_QA); f16* PL = (f16*)(F.ws + WS_PL); f16* CKV = (f16*)(F.ws + WS_CKV);
    f16* QG = (f16*)(F.ws + WS_QG); f16* KG = (f16*)(F.ws + WS_KG); f16* VG = (f16*)(F.ws + WS_VG); f16* KR = (f16*)(F.ws + WS_KR);
    const float* tabM = (const float*)(F.ws + WS_CTL + CTL_TABM); const float* tabG = (const float*)(F.ws + WS_CTL + CTL_TABG);
    const float* g_q_a = p.in[12] + l * 256; const float* g_kv_a = p.in[14] + l * 128; const float* g_q_gqa = p.in[16] + l * 64; const float* g_k_gqa = p.in[17] + l * 64;
    const int lane = F.lane;
    const int gw = F.vcu * NWAVES + F.wave, NGW = F.G * NWAVES;
    for (int row = gw; row < NTOK + 2 * PAST; row += NGW) {
        if (row >= NTOK) {
            const int cr = row - NTOK, b = cr / PAST, j = cr % PAST;
            const size_t kvrow = (size_t)NCTX + (size_t)KVL * b + SEQL + j;
            const size_t crow_ = ((size_t)b * 2 + l) * PAST + j;
            { const f32x2 v = *(const f32x2*)(p.in[3] + crow_ * 128 + 2 * lane); *(unsigned*)(CKV + kvrow * 128 + 2 * lane) = pk2h(v.x, v.y); }
            if (lane < 16) { const f32x2 v = *(const f32x2*)(p.in[4] + crow_ * 32 + 2 * lane); *(unsigned*)(KR + kvrow * 32 + 2 * lane) = pk2h(v.x, v.y); }
            { const f32x2 v = *(const f32x2*)(p.in[5] + crow_ * 128 + 2 * lane); *(unsigned*)(KG + kvrow * 128 + 2 * lane) = pk2h(v.x, v.y); }
            { const f32x2 v = *(const f32x2*)(p.in[6] + crow_ * 128 + 2 * lane); *(unsigned*)(VG + kvrow * 128 + 2 * lane) = pk2h(v.x, v.y); }
            continue;
        }
        const bool lat = row >= NCTX;
        const int tl = lat ? ((row - NCTX) & (SEQL - 1)) : (row & (SEQC - 1));
        const int T = lat ? SEQL : SEQC;
        const size_t kvrow = lat ? (size_t)NCTX + (size_t)KVL * ((row - NCTX) >> 12) + tl : (size_t)row;
        const int prow = tl >> 6, pcol = tl & 63;
        const f16* z = Z + (size_t)row * ZS;
        const size_t ob = lat ? 0 : ((size_t)(row >> 8) * 2 + l) * SEQC + tl;
        { const u32x2 w = *(const u32x2*)(z + ZC_QA + 4 * lane);
          float v0 = h_lo(w.x), v1 = h_hi(w.x), v2 = h_lo(w.y), v3 = h_hi(w.y);
          const float rstd = 1.0f / sqrtf(wave_sum(v0 * v0 + v1 * v1 + v2 * v2 + v3 * v3) * (1.0f / 256.0f) + RMS_EPS);
          const f32x4 g = *(const f32x4*)(g_q_a + 4 * lane);
          u32x2 o; o.x = pk2h(v0 * rstd * g.x, v1 * rstd * g.y); o.y = pk2h(v2 * rstd * g.z, v3 * rstd * g.w);
          *(u32x2*)(QA + (size_t)row * 256 + 4 * lane) = o; }
        { const unsigned w = *(const unsigned*)(z + ZC_CKV + 2 * lane);
          float v0 = h_lo(w), v1 = h_hi(w);
          const float rstd = 1.0f / sqrtf(wave_sum(v0 * v0 + v1 * v1) * (1.0f / 128.0f) + RMS_EPS);
          const f32x2 g = *(const f32x2*)(g_kv_a + 2 * lane);
          v0 = v0 * rstd * g.x; v1 = v1 * rstd * g.y;
          *(unsigned*)(CKV + kvrow * 128 + 2 * lane) = pk2h(v0, v1);
          if (!lat) *(f32x2*)(p.out + OUT_CKV + ob * 128 + 2 * lane) = (f32x2){v0, v1}; }
        { float v = (lane < 32) ? (float)z[ZC_KR + lane] : 0.f;
          if (!lat) { if (lane < 32) p.out[OUT_KR + ob * 32 + lane] = v; }
          else { const float other = __shfl_xor(v, 8); const int d = lane & 31, i = d & 15; const int pos = (d < 16) ? prow : pcol;
                 const float c = tabM[(pos * 8 + (i & 7)) * 2], s = tabM[(pos * 8 + (i & 7)) * 2 + 1];
                 v = (i < 8) ? (v * c - other * s) : (other * s + v * c); }
          if (lane < 32) KR[kvrow * 32 + lane] = (f16)v; }
        { const u32x4 w = *(const u32x4*)(z + ZC_GQ + 8 * lane);
          float v[8] = {h_lo(w.x), h_hi(w.x), h_lo(w.y), h_hi(w.y), h_lo(w.z), h_hi(w.z), h_lo(w.w), h_hi(w.w)};
          float s = 0.f;
#pragma unroll
          for (int e = 0; e < 8; ++e) s += v[e] * v[e];
          s += __shfl_xor(s, 1); s += __shfl_xor(s, 2); s += __shfl_xor(s, 4);
          const float rstd = 1.0f / sqrtf(s * (1.0f / 64.0f) + RMS_EPS);
          const int d0 = 8 * (lane & 7);
#pragma unroll
          for (int e = 0; e < 8; ++e) v[e] = v[e] * rstd * g_q_gqa[d0 + e];
          if (lat) { const int i0 = d0 & 31; const int pos = (d0 < 32) ? prow : pcol; const bool first = i0 < 16;
#pragma unroll
              for (int e = 0; e < 8; ++e) { const float other = __shfl_xor(v[e], 2); const int fi = (i0 & 15) + e;
                  const float c = tabG[(pos * 16 + fi) * 2], sn = tabG[(pos * 16 + fi) * 2 + 1];
                  v[e] = first ? (v[e] * c - other * sn) : (other * sn + v[e] * c); } }
#pragma unroll
          for (int e = 0; e < 8; ++e) v[e] *= SCALE_GQA;
          u32x4 o; o.x = pk2h(v[0], v[1]); o.y = pk2h(v[2], v[3]); o.z = pk2h(v[4], v[5]); o.w = pk2h(v[6], v[7]);
          *(u32x4*)(QG + (size_t)row * 512 + 8 * lane) = o; }
        { const unsigned w = *(const unsigned*)(z + ZC_GK + 2 * lane);
          float v0 = h_lo(w), v1 = h_hi(w);
          float s = v0 * v0 + v1 * v1;
#pragma unroll
          for (int o = 1; o < 32; o <<= 1) s += __shfl_xor(s, o);
          const float rstd = 1.0f / sqrtf(s * (1.0f / 64.0f) + RMS_EPS);
          const int d0 = 2 * (lane & 31);
          v0 = v0 * rstd * g_k_gqa[d0]; v1 = v1 * rstd * g_k_gqa[d0 + 1];
          if (!lat) *(f32x2*)(p.out + OUT_GK + ob * 128 + 2 * lane) = (f32x2){v0, v1};
          else { const int i0 = d0 & 31; const int pos = (d0 < 32) ? prow : pcol; const bool first = i0 < 16;
                 const float o0 = __shfl_xor(v0, 8), o1 = __shfl_xor(v1, 8); const int fi = i0 & 15;
                 const float c0 = tabG[(pos * 16 + fi) * 2], s0 = tabG[(pos * 16 + fi) * 2 + 1], c1 = tabG[(pos * 16 + fi + 1) * 2], s1 = tabG[(pos * 16 + fi + 1) * 2 + 1];
                 v0 = first ? (v0 * c0 - o0 * s0) : (o0 * s0 + v0 * c0); v1 = first ? (v1 * c1 - o1 * s1) : (o1 * s1 + v1 * c1); }
          *(unsigned*)(KG + kvrow * 128 + 2 * lane) = pk2h(v0, v1); }
        { const unsigned w = *(const unsigned*)(z + ZC_GV + 2 * lane);
          *(unsigned*)(VG + kvrow * 128 + 2 * lane) = w;
          if (!lat) *(f32x2*)(p.out + OUT_GV + ob * 128 + 2 * lane) = (f32x2){h_lo(w), h_hi(w)}; }
        { const int g = lane >> 4, wsz = 2 << g, c8 = (lane & 15) * 8;
          const int lo = max(tl - wsz / 2, 0), hi = min(tl - wsz / 2 + wsz, T);
          const f16* zc = z + ZC_PL + g * 128 + c8;
          float acc[8] = {0.f, 0.f, 0.f, 0.f, 0.f, 0.f, 0.f, 0.f};
          for (int k = 0; k < 16; ++k) {
              const int tt = lo + k;
              if (tt < hi) { const u32x4 w = *(const u32x4*)(zc + (ptrdiff_t)(tt - tl) * ZS);
                  acc[0] += h_lo(w.x); acc[1] += h_hi(w.x); acc[2] += h_lo(w.y); acc[3] += h_hi(w.y); acc[4] += h_lo(w.z); acc[5] += h_hi(w.z); acc[6] += h_lo(w.w); acc[7] += h_hi(w.w); }
          }
          const float inv = 1.0f / (float)(hi - lo);
          const u32x4 w = *(const u32x4*)zc;
          const float own[8] = {h_lo(w.x), h_hi(w.x), h_lo(w.y), h_hi(w.y), h_lo(w.z), h_hi(w.z), h_lo(w.w), h_hi(w.w)};
          u32x4 o; o.x = pk2h(acc[0] * inv - own[0], acc[1] * inv - own[1]); o.y = pk2h(acc[2] * inv - own[2], acc[3] * inv - own[3]);
          o.z = pk2h(acc[4] * inv - own[4], acc[5] * inv - own[5]); o.w = pk2h(acc[6] * inv - own[6], acc[7] * inv - own[7]);
          *(u32x4*)(PL + (size_t)row * 512 + g * 128 + c8) = o; }
    }
}

__device__ __forceinline__ void fixup_phase(const Frame& F_, const Params& p, int l) {
    Frame F = F_; { int t_ = threadIdx.x; asm volatile("" : "+v"(t_)); F.tid = t_; F.lane = t_ & 63; F.wave = __builtin_amdgcn_readfirstlane(t_ >> 6); }
    const float* E = (const float*)(F.ws + WS_EDGE); const float* VE = (const float*)(F.ws + WS_VEDGE); f16* act = (f16*)(F.ws + WS_ACT);
    const float* cw = p.in[26] + (size_t)l * 3 * DFF; const float* cb = p.in[27] + (size_t)l * DFF;
    const int gw = F.vcu * NWAVES + F.wave, NGW = F.G * NWAVES;
    for (int it = gw; it < 512; it += NGW) {
        const int chunk = it >> 1, side = it & 1;
        const int row = chunk * 64 + (side ? 63 : 0);
        const bool lat = row >= NCTX; const int tl = lat ? ((row - NCTX) & (SEQL - 1)) : (row & (SEQC - 1)); const int T = lat ? SEQL : SEQC;
        const float* prev; const float* cur; const float* nxt; bool hasp = true, hasn = true;
        if (side == 0) { hasp = tl > 0; prev = E + ((size_t)(chunk - 1) * 4 + 3) * DFF; cur = E + ((size_t)chunk * 4 + 0) * DFF; nxt = E + ((size_t)chunk * 4 + 1) * DFF; }
        else { hasn = tl < T - 1; prev = E + ((size_t)chunk * 4 + 2) * DFF; cur = E + ((size_t)chunk * 4 + 3) * DFF; nxt = E + ((size_t)(chunk + 1) * 4 + 0) * DFF; }
        const float* val = VE + ((size_t)chunk * 2 + side) * DFF;
        for (int c = 4 * F.lane; c < DFF; c += 256) {
            const f32x4 zero = {0.f, 0.f, 0.f, 0.f};
            const f32x4 pv = hasp ? *(const f32x4*)(prev + c) : zero, cv = *(const f32x4*)(cur + c), nv = hasn ? *(const f32x4*)(nxt + c) : zero, vv = *(const f32x4*)(val + c);
            const f32x4 g = *(const f32x4*)(cw + c) * pv + *(const f32x4*)(cw + DFF + c) * cv + *(const f32x4*)(cw + 2 * DFF + c) * nv + *(const f32x4*)(cb + c);
            u32x2 w; w.x = pk2h(siluf_(g.x) * vv.x, siluf_(g.y) * vv.y); w.y = pk2h(siluf_(g.z) * vv.z, siluf_(g.w) * vv.w);
            *(u32x2*)(act + (size_t)row * DFF + c) = w;
        }
    }
}

__device__ __forceinline__ void attn_one(const Frame& F, int kind  , int u) {
    const f16* QM = (const f16*)(F.ws + WS_QM); const f16* QG = (const f16*)(F.ws + WS_QG); const f16* KV = (const f16*)(F.ws + WS_KV);
    const f16* KR = (const f16*)(F.ws + WS_KR); const f16* KG = (const f16*)(F.ws + WS_KG); const f16* VG = (const f16*)(F.ws + WS_VG); f16* ABO = (f16*)(F.ws + WS_ABO);
    int tok0, kv0, ntiles, hh;
    if (kind == 0) { const int b = u >> 8, qb = u & 15; hh = (u >> 4) & 15; tok0 = NCTX + b * SEQL + qb * 256; kv0 = NCTX + b * KVL; ntiles = KVL / 64; }
    else { const int s = u >> 4; hh = u & 15; tok0 = s * SEQC; kv0 = s * SEQC; ntiles = SEQC / 64; }
    if (hh < 8) {
        attn::Src s{KV + (size_t)kv0 * 1024 + hh * 128, 1024, KR + (size_t)kv0 * 32, 32, KV + (size_t)kv0 * 1024 + hh * 128 + 64, 1024};
        attn::unit<96>(F.lds, QM + (size_t)tok0 * 768 + hh * 96, 768, s, ntiles, ABO + (size_t)tok0 * 1024 + hh * 64, 1024);
    } else {
        const int h = hh - 8, g = h >> 2;
        attn::Src s{KG + (size_t)kv0 * 128 + g * 64, 128, nullptr, 0, VG + (size_t)kv0 * 128 + g * 64, 128};
        attn::unit<64>(F.lds, QG + (size_t)tok0 * 512 + h * 64, 512, s, ntiles, ABO + (size_t)tok0 * 1024 + 512 + h * 64, 1024);
    }
}
__device__ __forceinline__ void attn_phase(const Frame& F) {
    for (int u = F.vcu; u < 256; u += F.G) { attn_one(F, 0, u); attn_one(F, 0, 511 - u); }
    for (int u = F.vcu; u < 256; u += F.G) { attn_one(F, 1, u); attn_one(F, 1, 511 - u); }
}

__global__ void __launch_bounds__(NTHREADS, 2) fwd_kernel(Params p) {
    extern __shared__ __attribute__((aligned(16))) unsigned char lds_raw[];
    Frame F;
    F.lds = (LAS unsigned char*)lds_raw;
    F.tid = 0; F.lane = 0; F.wave = 0;
    F.G = gridDim.x; { const int bx = blockIdx.x; F.vcu = (F.G % 8 == 0) ? (bx % 8) * (F.G / 8) + bx / 8 : bx; }
    F.ws = p.ws; F.out = p.out;
#if USE_CG
    cg::grid_group grid = cg::this_grid();
#define GRID_BAR() grid.sync()
#else
    { cg::grid_group grid = cg::this_grid(); if (p.ws == nullptr) grid.sync(); }
    for (int u = threadIdx.x; u < (LDS_BYTES - LDSCTL_OFF) / 4; u += NTHREADS) ((LAS unsigned*)(F.lds + LDSCTL_OFF))[u] = 0u;
    __syncthreads();
    XcdBarrier bar = xcd_barrier_post((unsigned*)(F.ws + WS_CTL) + 1024, (volatile LAS unsigned*)(F.lds + LDSCTL_OFF + 64));
#define GRID_BAR() xcd_barrier(bar)
#endif
    unsigned char* ws = F.ws;
    const float* modf = (const float*)(ws + WS_CTL + CTL_MOD);

    RUNPH(0, p0_convert(F, p); __syncthreads(); p0_mod(F, p); p0_tables(F));
    GRID_BAR();

#pragma unroll 1
    for (int step = 0; step < 26; ++step) {
        const int l = step / 13, k = step % 13;
        unsigned char* wl = ws + WS_W + (size_t)l * WL_BYTES;
        const float* modl = modf + (size_t)l * 3 * NMOD;
        const float* xP = (l == 0) ? p.in[0] : p.out;
        const float* xS = (l == 0) ? p.in[1] : p.out + (size_t)NCTX * DM;
        bool do_bar = true;
        if (k == 0 || k == 9) {
            const float* nP = (k == 0) ? xP : p.out; const float* nS = (k == 0) ? xS : p.out + (size_t)NCTX * DM;
            const float* ng = (k == 0) ? p.in[10] + l * DM : p.in[24] + l * DM; const float* nm = (k == 0) ? modl : modl + 3072;
            RUNPH(1, norm_mod_phase(F, nP, nS, ng, nm, nm + 1024, (f16*)(ws + WS_H)));
        } else if (k == 1 || k == 3 || k == 4 || k == 5) {
            pg8::SchedPlain S; pg8::EpiF16 E;
            if (k == 1)      { S.T.init(64, 7, F.G, (int)blockIdx.x); S.A = (const char*)(ws + WS_H);   S.B = (const char*)(wl + WO_IN);   S.lda = 1024; S.ldb = 1024; S.nt = 16; S.koff = 0;
                               E = pg8::EpiF16{(f16*)(ws + WS_ZS), ZS, 0, nullptr, 1.f}; }
            else if (k == 3) { S.T.init(64, 3, F.G, (int)blockIdx.x); S.A = (const char*)(ws + WS_QA);  S.B = (const char*)(wl + WO_QB);   S.lda = 256;  S.ldb = 256;  S.nt = 4;  S.koff = 0;
                               E = pg8::EpiF16{(f16*)(ws + WS_QM), 768, 1, (const float*)(ws + WS_CTL + CTL_TABM), SCALE_MLA}; do_bar = false; }
            else if (k == 4) { S.T.init(68, 4, F.G, (int)blockIdx.x); S.A = (const char*)(ws + WS_CKV); S.B = (const char*)(wl + WO_KVB);  S.lda = 128;  S.ldb = 128;  S.nt = 2;  S.koff = 0;
                               E = pg8::EpiF16{(f16*)(ws + WS_KV), 1024, 0, nullptr, 1.f}; do_bar = false; }
            else             { S.T.init(64, 2, F.G, (int)blockIdx.x); S.A = (const char*)(ws + WS_PL);  S.B = (const char*)(wl + WO_POOL); S.lda = 512;  S.ldb = 512;  S.nt = 4;  S.koff = 256;
                               E = pg8::EpiF16{(f16*)(ws + WS_CO), 1024, 2, p.in[19] + l * 512, 1.f}; }
            RUNPH(2, pg8::gemm_phase<pg8::EpiF16, pg8::SchedPlain, true>(F.lds, S.lda, S.ldb, S, E));
        } else if (k == 2) {
            RUNPH(3, token_phase(F, p, l));
        } else if (k == 6) {
            RUNPH(7, attn_phase(F));
        } else if (k == 7) {
            pg8::SchedMerge S; S.T.init(64, 4, F.G, (int)blockIdx.x); S.Hh = (const char*)(ws + WS_H); S.ABO = (const char*)(ws + WS_ABO); S.CO = (const char*)(ws + WS_CO);
            S.Wg = (const char*)(wl + WO_G); S.Wab = (const char*)(wl + WO_BRAB); S.Wc = (const char*)(wl + WO_BRC);
            pg8::EpiMerge E{ws + WS_GSCR + (size_t)blockIdx.x * 131072, (f16*)(ws + WS_MERGED)};
            RUNPH(8, pg8::gemm_phase<pg8::EpiMerge, pg8::SchedMerge, false>(F.lds, 1024, 1024, S, E));
        } else if (k == 8 || k == 12) {
            pg8::SchedPlain S; pg8::EpiRes E;
            S.T.init(64, 4, F.G, (int)blockIdx.x); S.koff = 0;
            if (k == 8) { S.A = (const char*)(ws + WS_MERGED); S.B = (const char*)(wl + WO_OUT);  S.lda = 1024; S.ldb = 1024; S.nt = 16; E = pg8::EpiRes{xP, xS, p.out, modl + 2048}; }
            else        { S.A = (const char*)(ws + WS_ACT);    S.B = (const char*)(wl + WO_DOWN); S.lda = DFF;  S.ldb = DFF;  S.nt = 44; E = pg8::EpiRes{p.out, p.out + (size_t)NCTX * DM, p.out, modl + 5120}; }
            pg8::gemm_phase<pg8::EpiRes, pg8::SchedPlain, false>(F.lds, S.lda, S.ldb, S, E);
        } else if (k == 10) {
            pg8::SchedPlain S; S.T.init(64, 22, F.G, (int)blockIdx.x); S.A = (const char*)(ws + WS_H); S.B = (const char*)(wl + WO_UP); S.lda = 1024; S.ldb = 1024; S.nt = 16; S.koff = 0;
            pg8::EpiUp E{(f16*)(ws + WS_ACT), (float*)(ws + WS_EDGE), (float*)(ws + WS_VEDGE), p.in[26] + (size_t)l * 3 * DFF, p.in[27] + (size_t)l * DFF};
            RUNPH(11, pg8::gemm_phase<pg8::EpiUp, pg8::SchedPlain, true>(F.lds, 1024, 1024, S, E));
        } else {
            RUNPH(12, fixup_phase(F, p, l));
        }
        if (do_bar) GRID_BAR();
    }
    final_norm_phase(F, p.out, p.in[29]);
}

extern "C" void kernel_launch(void* const* d_in, const int* in_sizes, int n_in, void* d_out, int out_size, void* d_ws, size_t ws_size, hipStream_t stream) {
    static int grid = 0;
    if (grid == 0) {
        if (n_in != 30 || ws_size < WS_END) { fprintf(stderr, "kernel_launch: unexpected arguments (n_in %d, ws %zu)\n", n_in, ws_size); grid = -1; return; }
        int dev = 0, cus = 0, per_cu = 0;
        hipGetDevice(&dev);
        hipDeviceGetAttribute(&cus, hipDeviceAttributeMultiprocessorCount, dev);
        hipFuncSetAttribute((const void*)fwd_kernel, hipFuncAttributeMaxDynamicSharedMemorySize, LDS_BYTES);
        hipOccupancyMaxActiveBlocksPerMultiprocessor(&per_cu, (const void*)fwd_kernel, NTHREADS, LDS_BYTES);
        if (per_cu < 1) { fprintf(stderr, "kernel_launch: occupancy query says %d blocks per CU\n", per_cu); per_cu = 1; }
        (void)hipGetLastError();
        grid = cus;
    }
    if (grid < 0) return;
    hipMemsetAsync((char*)d_ws + WS_CTL, 0, CTL_ZERO_BYTES, stream);
    Params p{};
    for (int i = 0; i < 30; ++i) p.in[i] = (const float*)d_in[i];
    p.out = (float*)d_out; p.ws = (unsigned char*)d_ws;
    void* args[] = {&p};
    hipError_t e = hipLaunchCooperativeKernel((const void*)fwd_kernel, dim3(grid), dim3(NTHREADS), args, LDS_BYTES, stream);
    if (e != hipSuccess) fprintf(stderr, "kernel_launch: cooperative launch failed: %s (grid %d)\n", hipGetErrorString(e), grid);
}
```
